# Optimizing an MI355X kernel written in HIP

```python
import math
import jax, jax.numpy as jnp
from jax import lax
import numpy as np

D_MODEL = 1024
BATCH = 8
SEQ = 2048
DEPTH = 2

N_A_LAYERS = DEPTH // 2
N_B_LAYERS = DEPTH - N_A_LAYERS
N_DENSE_FFN = (DEPTH + 1) // 2
N_MOE_FFN = DEPTH // 2
RMS_EPS = 1e-6
ROPE_THETA = 500000.0
NEG_INF = -1e30

MLA_HEADS = 16
MLA_NOPE_DIM = 64
MLA_ROPE_DIM = 32
MLA_V_DIM = 64
MLA_Q_LORA = 384
MLA_KV_LORA = 256
MLA_QK_DIM = MLA_NOPE_DIM + MLA_ROPE_DIM
MLA_DOWN_DIM = MLA_Q_LORA + MLA_KV_LORA + MLA_ROPE_DIM
Q_BLOCK = 128

DSW_BRANCHES = ((128, 1), (512, 4), (2048, 16))
N_BR = len(DSW_BRANCHES)
DSW_HEADS = 16
DSW_HEAD_DIM = 64
DSW_ROT_DIM = DSW_HEAD_DIM // 4
DSW_WIDTH = DSW_HEADS * DSW_HEAD_DIM
DSW_BLOCK = 128

FFN_DIM = 2816
N_EXPERTS = 8
TOP_K = 2
EXPERT_DIM = 3584

kernel_name = "yoco_mla_dilated_moe_trunk"


def rmsnorm(x, g):
    x32 = x.astype(jnp.float32)
    y = x32 * lax.rsqrt(jnp.mean(x32 * x32, axis=-1, keepdims=True) + RMS_EPS)
    return (y * g.astype(jnp.float32)).astype(x.dtype)


def rope(t, pos, rot_dim):
    half = rot_dim // 2
    inv_freq = jnp.power(jnp.float32(ROPE_THETA), -jnp.arange(half, dtype=jnp.float32) * (2.0 / rot_dim))
    ang = pos.astype(jnp.float32)[..., None] * inv_freq
    cos = jnp.cos(ang)[:, :, None, :]
    sin = jnp.sin(ang)[:, :, None, :]
    x1 = t[..., :half].astype(jnp.float32)
    x2 = t[..., half:rot_dim].astype(jnp.float32)
    rot = jnp.concatenate([x1 * cos - x2 * sin, x2 * cos + x1 * sin], axis=-1).astype(t.dtype)
    return jnp.concatenate([rot, t[..., rot_dim:]], axis=-1)


def blocked_causal_attention(q, k, v, scale):
    B, S, H, dq = q.shape
    dv = v.shape[-1]
    nb = S // Q_BLOCK
    qb = q.reshape(B, nb, Q_BLOCK, H, dq).transpose(1, 0, 2, 3, 4)
    kpos = jnp.arange(S)

    def one_block(args):
        q_blk, i = args
        s = jnp.einsum('bqhd,bkhd->bhqk', q_blk, k).astype(jnp.float32) * scale
        qpos = i * Q_BLOCK + jnp.arange(Q_BLOCK)
        s = jnp.where(kpos[None, :] <= qpos[:, None], s, NEG_INF)
        p = jax.nn.softmax(s, axis=-1).astype(v.dtype)
        return jnp.einsum('bhqk,bkhd->bqhd', p, v)

    o = lax.map(one_block, (qb, jnp.arange(nb)))
    return o.transpose(1, 0, 2, 3, 4).reshape(B, S, H, dv)


def mla_attention(xn, pos, w_down, q_norm, w_uq, kv_norm, w_ukv, w_o):
    B, S, _ = xn.shape
    down = xn @ w_down
    c_q = rmsnorm(down[..., :MLA_Q_LORA], q_norm)
    c_kv = rmsnorm(down[..., MLA_Q_LORA:MLA_Q_LORA + MLA_KV_LORA], kv_norm)
    k_rope = rope(down[..., None, MLA_Q_LORA + MLA_KV_LORA:], pos, MLA_ROPE_DIM)
    q = (c_q @ w_uq).reshape(B, S, MLA_HEADS, MLA_QK_DIM)
    q = jnp.concatenate([q[..., :MLA_NOPE_DIM], rope(q[..., MLA_NOPE_DIM:], pos, MLA_ROPE_DIM)], axis=-1)
    kv = (c_kv @ w_ukv).reshape(B, S, MLA_HEADS, MLA_NOPE_DIM + MLA_V_DIM)
    k = jnp.concatenate([kv[..., :MLA_NOPE_DIM],
                         jnp.broadcast_to(k_rope, (B, S, MLA_HEADS, MLA_ROPE_DIM))], axis=-1)
    v = kv[..., MLA_NOPE_DIM:]
    o = blocked_causal_attention(q, k, v, 1.0 / math.sqrt(MLA_QK_DIM))
    return o.reshape(B, S, MLA_HEADS * MLA_V_DIM) @ w_o


def shared_dsw_kv(h, pos, kv_norm, w_kv):
    B, S, _ = h.shape
    kv = (rmsnorm(h, kv_norm) @ w_kv).reshape(B, S, 2, N_BR, DSW_HEADS, DSW_HEAD_DIM)
    k = rope(kv[:, :, 0].reshape(B, S, N_BR * DSW_HEADS, DSW_HEAD_DIM), pos, DSW_ROT_DIM)
    return k.reshape(B, S, N_BR, DSW_HEADS, DSW_HEAD_DIM), kv[:, :, 1]


def dilated_branch(q, k, v, window, dilation):
    B, S, H, hd = q.shape
    L = S // dilation
    w_sub = window // dilation
    nb = -(-L // DSW_BLOCK)
    Lp = nb * DSW_BLOCK

    def to_sub(t):
        return t.reshape(B, L, dilation, H, hd).transpose(0, 2, 1, 3, 4)

    qs = jnp.pad(to_sub(q), ((0, 0), (0, 0), (0, Lp - L), (0, 0), (0, 0)))
    pad_kv = ((0, 0), (0, 0), (DSW_BLOCK, Lp - L), (0, 0), (0, 0))
    ks = jnp.pad(to_sub(k), pad_kv).reshape(B, dilation, nb + 1, DSW_BLOCK, H, hd)
    vs = jnp.pad(to_sub(v), pad_kv).reshape(B, dilation, nb + 1, DSW_BLOCK, H, hd)
    k_win = jnp.concatenate([ks[:, :, :-1], ks[:, :, 1:]], axis=3)
    v_win = jnp.concatenate([vs[:, :, :-1], vs[:, :, 1:]], axis=3)
    qb = qs.reshape(B, dilation, nb, DSW_BLOCK, H, hd)

    s = jnp.einsum('brnqhd,brnkhd->brnhqk', qb, k_win).astype(jnp.float32) * (1.0 / math.sqrt(hd))
    a = jnp.arange(DSW_BLOCK)[:, None]
    b = jnp.arange(2 * DSW_BLOCK)[None, :]
    dist = a + DSW_BLOCK - b
    key_sub = jnp.arange(nb)[:, None, None] * DSW_BLOCK - DSW_BLOCK + b[None]
    valid = (dist >= 0)[None] & (dist <= w_sub)[None] & (key_sub >= 0)
    s = jnp.where(valid[None, None, :, None], s, NEG_INF)
    lse = jax.nn.logsumexp(s, axis=-1)
    p = jnp.exp(s - lse[..., None]).astype(v.dtype)
    o = jnp.einsum('brnhqk,brnkhd->brnqhd', p, v_win)

    def from_sub(t):
        t = t.reshape(B, dilation, Lp, H, t.shape[-1])[:, :, :L]
        return t.transpose(0, 2, 1, 3, 4).reshape(B, S, H, t.shape[-1])

    o = from_sub(o)
    lse = from_sub(lse.transpose(0, 1, 2, 4, 3)[..., None])[..., 0]
    return o, lse


def dsw_attention(xn, pos, k_sh, v_sh, w_q, w_o):
    B, S, _ = xn.shape
    q = (xn @ w_q).reshape(B, S, N_BR * DSW_HEADS, DSW_HEAD_DIM)
    q = rope(q, pos, DSW_ROT_DIM).reshape(B, S, N_BR, DSW_HEADS, DSW_HEAD_DIM)
    outs, lses = [], []
    for g, (window, dilation) in enumerate(DSW_BRANCHES):
        o, lse = dilated_branch(q[:, :, g], k_sh[:, :, g], v_sh[:, :, g], window, dilation)
        outs.append(o)
        lses.append(lse)
    wts = jax.nn.softmax(jnp.stack(lses, axis=0), axis=0)
    o = jnp.sum(wts[..., None].astype(xn.dtype) * jnp.stack(outs, axis=0), axis=0)
    return o.reshape(B, S, DSW_WIDTH) @ w_o


def swiglu(xn, wg, wu, wd):
    return (jax.nn.silu(xn @ wg) * (xn @ wu)) @ wd


def moe_swiglu(xn, router, wg, wu, wd):
    logits = (xn @ router).astype(jnp.float32)
    top_vals, top_idx = lax.top_k(logits, TOP_K)
    gates = jax.nn.softmax(top_vals, axis=-1)
    combine = jnp.sum(jax.nn.one_hot(top_idx, N_EXPERTS, dtype=jnp.float32) * gates[..., None], axis=-2)
    out = jnp.zeros_like(xn)
    for e in range(N_EXPERTS):
        out = out + combine[..., e:e + 1].astype(xn.dtype) * swiglu(xn, wg[e], wu[e], wd[e])
    return out


def setup_inputs(seed: int = 0) -> dict:
    key = jax.random.key(seed)
    ks = iter(jax.random.split(key, 32))

    def w(shape, fan_in):
        return jax.random.normal(next(ks), shape, jnp.float32) * (fan_in ** -0.5)

    def gain(shape):
        return 1.0 + 0.05 * jax.random.normal(next(ks), shape, jnp.float32)

    x = jax.random.normal(next(ks), (BATCH, SEQ, D_MODEL), jnp.float32)
    offs = jax.random.randint(next(ks), (BATCH, 1), 0, 8192, dtype=jnp.int32)
    positions = offs + jnp.arange(SEQ, dtype=jnp.int32)[None, :]
    return {
        "x": x,
        "positions": positions,
        "norm_attn": gain((DEPTH, D_MODEL)),
        "norm_ffn": gain((DEPTH, D_MODEL)),
        "mla_w_down": w((N_A_LAYERS, D_MODEL, MLA_DOWN_DIM), D_MODEL),
        "mla_q_norm": gain((N_A_LAYERS, MLA_Q_LORA)),
        "mla_w_uq": w((N_A_LAYERS, MLA_Q_LORA, MLA_HEADS * MLA_QK_DIM), MLA_Q_LORA),
        "mla_kv_norm": gain((N_A_LAYERS, MLA_KV_LORA)),
        "mla_w_ukv": w((N_A_LAYERS, MLA_KV_LORA, MLA_HEADS * (MLA_NOPE_DIM + MLA_V_DIM)), MLA_KV_LORA),
        "mla_w_o": w((N_A_LAYERS, MLA_HEADS * MLA_V_DIM, D_MODEL), MLA_HEADS * MLA_V_DIM),
        "dsw_kv_norm": gain((D_MODEL,)),
        "dsw_w_kv": w((D_MODEL, 2 * N_BR * DSW_WIDTH), D_MODEL),
        "dsw_w_q": w((N_B_LAYERS, D_MODEL, N_BR * DSW_WIDTH), D_MODEL),
        "dsw_w_o": w((N_B_LAYERS, DSW_WIDTH, D_MODEL), DSW_WIDTH),
        "ffn_w_gate": w((N_DENSE_FFN, D_MODEL, FFN_DIM), D_MODEL),
        "ffn_w_up": w((N_DENSE_FFN, D_MODEL, FFN_DIM), D_MODEL),
        "ffn_w_down": w((N_DENSE_FFN, FFN_DIM, D_MODEL), FFN_DIM),
        "moe_router": w((N_MOE_FFN, D_MODEL, N_EXPERTS), D_MODEL),
        "moe_w_gate": w((N_MOE_FFN, N_EXPERTS, D_MODEL, EXPERT_DIM), D_MODEL),
        "moe_w_up": w((N_MOE_FFN, N_EXPERTS, D_MODEL, EXPERT_DIM), D_MODEL),
        "moe_w_down": w((N_MOE_FFN, N_EXPERTS, EXPERT_DIM, D_MODEL), EXPERT_DIM),
        "final_norm": gain((D_MODEL,)),
    }


def reference(x, positions, norm_attn, norm_ffn, mla_w_down, mla_q_norm, mla_w_uq, mla_kv_norm,
              mla_w_ukv, mla_w_o, dsw_kv_norm, dsw_w_kv, dsw_w_q, dsw_w_o, ffn_w_gate, ffn_w_up,
              ffn_w_down, moe_router, moe_w_gate, moe_w_up, moe_w_down, final_norm):
    h = x
    k_sh = v_sh = None
    for layer in range(DEPTH):
        xn = rmsnorm(h, norm_attn[layer])
        if layer < N_A_LAYERS:
            i = layer
            h = h + mla_attention(xn, positions, mla_w_down[i], mla_q_norm[i], mla_w_uq[i],
                                  mla_kv_norm[i], mla_w_ukv[i], mla_w_o[i])
        else:
            if layer == N_A_LAYERS:
                k_sh, v_sh = shared_dsw_kv(h, positions, dsw_kv_norm, dsw_w_kv)
                xn = rmsnorm(h, norm_attn[layer])
            i = layer - N_A_LAYERS
            h = h + dsw_attention(xn, positions, k_sh, v_sh, dsw_w_q[i], dsw_w_o[i])
        hn = rmsnorm(h, norm_ffn[layer])
        j = layer // 2
        if layer % 2 == 0:
            h = h + swiglu(hn, ffn_w_gate[j], ffn_w_up[j], ffn_w_down[j])
        else:
            h = h + moe_swiglu(hn, moe_router[j], moe_w_gate[j], moe_w_up[j], moe_w_down[j])
    return rmsnorm(h, final_norm)
```

```cpp
#include <hip/hip_runtime.h>
#include <cstdio>
#include <cstdint>

#define LAS __attribute__((address_space(3)))
#define GAS __attribute__((address_space(1)))
typedef unsigned short bf16_t;
typedef short bf16x8 __attribute__((ext_vector_type(8)));
typedef short s16x4 __attribute__((ext_vector_type(4)));
typedef float f32x2 __attribute__((ext_vector_type(2)));
typedef float f32x4 __attribute__((ext_vector_type(4)));
typedef float f32x16 __attribute__((ext_vector_type(16)));
typedef unsigned u32x2 __attribute__((ext_vector_type(2)));
typedef unsigned u32x4 __attribute__((ext_vector_type(4)));
typedef __bf16 bf16x2_t __attribute__((ext_vector_type(2)));

#ifndef MK_PER_PHASE
#define MK_PER_PHASE 0
#endif
#ifndef FFN8
#define FFN8 0
#endif
#ifndef FFN8D
#define FFN8D 1
#endif
#ifndef FP8_WGM
#define FP8_WGM 4
#endif
#ifndef DBG_STOP
#define DBG_STOP 0
#endif

__device__ __forceinline__ unsigned pk2(float lo, float hi) { f32x2 v = {lo, hi}; bf16x2_t b = __builtin_convertvector(v, bf16x2_t); return __builtin_bit_cast(unsigned, b); }
__device__ __forceinline__ unsigned pk4f8(float a, float b, float c, float d) { unsigned w = 0u; w = __builtin_amdgcn_cvt_pk_fp8_f32(a, b, w, false); w = __builtin_amdgcn_cvt_pk_fp8_f32(c, d, w, true); return w; }
__device__ __forceinline__ float fclamp8(float v) { return __builtin_fminf(__builtin_fmaxf(v, -448.f), 448.f); }
__device__ __forceinline__ float bflo(unsigned u) { return __uint_as_float(u << 16); }
__device__ __forceinline__ float bfhi(unsigned u) { return __uint_as_float(u & 0xffff0000u); }
__device__ __forceinline__ float wave_sum(float v) {
#pragma unroll
    for (int o = 1; o < 64; o <<= 1) v += __shfl_xor(v, o);
    return v;
}

constexpr int BATCH = 8, SEQ = 2048, M = BATCH * SEQ, D = 1024;
constexpr int QL = 384, KVL = 256, DOWN_N = 768  , UQ_N = 1536, UKV_N = 2048;
constexpr int FF = 2816, GU_N = 2 * FF, KVQ_N = 9216;
constexpr int NE = 8, EF = 3584, EGU_N = 2 * EF, RMAX = 34816;
constexpr float RMS_EPS = 1e-6f;
constexpr float LOG2E = 1.4426950408889634f;
constexpr float QSCALE_MLA = 0.10206207261596575f * LOG2E;
constexpr float QSCALE_DSW = 0.125f * LOG2E;

namespace pg8 {
constexpr int BM = 256, BK = 64, HALF = 128, HTB = HALF * BK * 2, STAGE_BYTES = 8 * HTB, NXCD = 8, WGM = 4;
__host__ __device__ __forceinline__ int lds_byte(int r, int c) { const int st = (r >> 4) * 2 + (c >> 5), rr = r & 15, cc = c & 31, ob = rr * 64 + cc * 2; return st * 1024 + (ob ^ (((ob >> 9) & 1) << 5)); }
__host__ __device__ __forceinline__ void stage_rc(int b, int& R, int& C) { const int st = b / 1024, sb = b % 1024, swz = sb ^ (((sb >> 9) & 1) << 5); R = (st >> 1) * 16 + swz / 64; C = (st & 1) * 32 + (swz % 64) / 2; }
__host__ __device__ __forceinline__ int perm32(int rho) { const int n = rho >> 4, i = rho & 15; return 8 * (i >> 2) + 4 * n + (i & 3); }

struct Unit { int pm, pn, e, ks; };
struct Gemm { const void* A; const void* Bt; int kb, lda, ldb; size_t bgs; int kso = 0; };
typedef int v4i_t __attribute__((ext_vector_type(4)));
typedef int v8i_t __attribute__((ext_vector_type(8)));

struct StaticOrder {
    int nM, nN, nwg, G, c, dup, wgm; const LAS unsigned* tile_e;
    __device__ void init(int nM_, int nN_, int G_, int c_, const LAS unsigned* te, int dup_ = 1) { nM = nM_; nN = nN_; nwg = nM * nN; G = G_; c = c_; tile_e = te; dup = dup_; wgm = WGM; }
    __device__ bool next(int i, Unit& u) const {
#if defined(DUP_CYCLIC) && DUP_CYCLIC
        const int nround = (nwg - c + G - 1) / G;
        if (nround <= 0 || i >= nround * dup) return false;
        const long L = (long)(i % nround) * G + c;
#else
        const long L = (long)(i / dup) * G + c; if (L >= nwg) return false;
#endif
        int wgid = (int)L; { const int q = nwg / NXCD, r = nwg % NXCD, xcd = wgid % NXCD, off = wgid / NXCD; wgid = (xcd < r ? xcd * (q + 1) : r * (q + 1) + (xcd - r) * q) + off; }
        const int nig = wgm * nN, gid = wgid / nig, fm = gid * wgm, gsz = (nM - fm) < wgm ? (nM - fm) : wgm;
        u.pm = fm + ((wgid % nig) % gsz); u.pn = (wgid % nig) / gsz;
        u.e = tile_e ? (int)__builtin_amdgcn_readfirstlane(tile_e[u.pm]) : 0; u.ks = 0;
        return true;
    }
};

struct SliceOrder {
    int pm0, nN, ns, nwg, G, c; const LAS unsigned* tile_e;
    __device__ void init(int pm0_, int nM_, int nN_, int ns_, int G_, int c_, const LAS unsigned* te) { pm0 = pm0_; nN = nN_; ns = ns_; nwg = (nM_ > 0 ? nM_ : 0) * nN_ * ns_; G = G_; c = c_; tile_e = te; }
    __device__ __forceinline__ bool next(int i, Unit& u) const {
        const long L = (long)i * G + c; if (L >= nwg) return false;
        const int t = (int)L / ns; u.ks = (int)L - t * ns; u.pm = pm0 + t / nN; u.pn = t % nN;
        u.e = tile_e ? (int)__builtin_amdgcn_readfirstlane(tile_e[u.pm]) : 0;
        return true;
    }
};

__device__ __forceinline__ float row_rstd(const float* ssq, int row) {
    const f32x4* p = (const f32x4*)(ssq + (size_t)row * 16); const f32x4 a = p[0], b = p[1], c = p[2], d = p[3];
    const float s = (((a[0] + a[1]) + (a[2] + a[3])) + ((b[0] + b[1]) + (b[2] + b[3]))) + (((c[0] + c[1]) + (c[2] + c[3])) + ((d[0] + d[1]) + (d[2] + d[3])));
    return 1.0f / sqrtf(s * (1.f / D) + RMS_EPS);
}
template <int STRIDE, int LO, int HALFN, int DIM>
__device__ __forceinline__ void rstd_prep_g(const float* ssq, int pm, int tid, LAS unsigned char* xl) {
    const float* p = ssq + ((size_t)pm * BM + (tid >> 1)) * STRIDE + LO + HALFN * (tid & 1);
    float s2 = 0.f;
    if constexpr (HALFN % 4 == 0) {
#pragma unroll
        for (int q = 0; q < HALFN / 4; ++q) { const f32x4 a = *(const f32x4*)(p + 4 * q); s2 += (a[0] + a[1]) + (a[2] + a[3]); }
    } else {
#pragma unroll
        for (int q = 0; q < HALFN / 2; ++q) { const f32x2 a = *(const f32x2*)(p + 2 * q); s2 += a[0] + a[1]; }
    }
    s2 += __shfl_xor(s2, 1);
    if ((tid & 1) == 0) ((LAS float*)xl)[tid >> 1] = 1.0f / sqrtf(s2 * (1.f / DIM) + RMS_EPS);
    asm volatile("s_waitcnt lgkmcnt(0)" ::: "memory"); __builtin_amdgcn_s_barrier(); asm volatile("" ::: "memory");
}
__device__ __forceinline__ void rstd_prep(const float* ssq, int pm, int tid, LAS unsigned char* xl) { rstd_prep_g<16, 0, 8, D>(ssq, pm, tid, xl); }
struct EpiBf16 {
    static constexpr bool PERM = true, HAS_PREP = false;
    bf16_t* O; int ldc; float sc;
    __device__ __forceinline__ void operator()(const f32x4 (&acc)[2][2][4][2], const Unit& u, int wr, int wc, int fr, int fq, const LAS unsigned char* xl) const {
        const int row0 = u.pm * BM + wr * 64 + fr, col0 = u.pn * BM + wc * 32 + 8 * fq;
#pragma unroll
        for (int ai = 0; ai < 2; ++ai)
#pragma unroll
            for (int m = 0; m < 4; ++m) { bf16_t* rowp = O + (size_t)(row0 + ai * HALF + m * 16) * ldc + col0;
#pragma unroll
                for (int bj = 0; bj < 2; ++bj) { const f32x4 v0 = acc[ai][bj][m][0] * sc, v1 = acc[ai][bj][m][1] * sc;
                    u32x4 w; w.x = pk2(v0[0], v0[1]); w.y = pk2(v0[2], v0[3]); w.z = pk2(v1[0], v1[1]); w.w = pk2(v1[2], v1[3]);
                    *(u32x4*)(rowp + bj * HALF) = w; } }
    }
};
struct EpiBf16S {
    static constexpr bool PERM = true, HAS_PREP = false;
    bf16_t* O; int ldc; float sc; int pm0; size_t sst;
    __device__ __forceinline__ void operator()(const f32x4 (&acc)[2][2][4][2], const Unit& u, int wr, int wc, int fr, int fq, const LAS unsigned char* xl) const {
        const int row0 = (u.pm - pm0) * BM + wr * 64 + fr, col0 = u.pn * BM + wc * 32 + 8 * fq;
        bf16_t* Os = O + (size_t)u.ks * sst;
#pragma unroll
        for (int ai = 0; ai < 2; ++ai)
#pragma unroll
            for (int m = 0; m < 4; ++m) { bf16_t* rowp = Os + (size_t)(row0 + ai * HALF + m * 16) * ldc + col0;
#pragma unroll
                for (int bj = 0; bj < 2; ++bj) { const f32x4 v0 = acc[ai][bj][m][0] * sc, v1 = acc[ai][bj][m][1] * sc;
                    u32x4 w; w.x = pk2(v0[0], v0[1]); w.y = pk2(v0[2], v0[3]); w.z = pk2(v1[0], v1[1]); w.w = pk2(v1[2], v1[3]);
                    *(u32x4*)(rowp + bj * HALF) = w; } }
    }
};
struct EpiF8 {
    static constexpr bool PERM = true, HAS_PREP = false;
    unsigned char* O; int ldc; float sc;
    __device__ __forceinline__ void operator()(const f32x4 (&acc)[2][2][4][2], const Unit& u, int wr, int wc, int fr, int fq, const LAS unsigned char* xl) const {
        const int row0 = u.pm * BM + wr * 64 + fr, col0 = u.pn * BM + wc * 32 + 8 * fq;
        u32x2 wprev[2] = {};
#pragma unroll
        for (int ai = 0; ai < 2; ++ai)
#pragma unroll
            for (int m = 0; m < 4; ++m) {
#pragma unroll
                for (int bj = 0; bj < 2; ++bj) { const f32x4 v0 = acc[ai][bj][m][0] * sc, v1 = acc[ai][bj][m][1] * sc;
                    u32x2 w; w.x = pk4f8(fclamp8(v0[0]), fclamp8(v0[1]), fclamp8(v0[2]), fclamp8(v0[3])); w.y = pk4f8(fclamp8(v1[0]), fclamp8(v1[1]), fclamp8(v1[2]), fclamp8(v1[3]));
                    if ((m & 1) == 0) wprev[bj] = w;
                    else { const auto r0 = __builtin_amdgcn_permlane16_swap(wprev[bj].x, w.x, false, false), r1 = __builtin_amdgcn_permlane16_swap(wprev[bj].y, w.y, false, false);
                        const u32x4 q = {r0[0], r1[0], r0[1], r1[1]};
                        *(u32x4*)(O + (size_t)(row0 + ai * HALF + (m - 1 + (fq & 1)) * 16) * ldc + (col0 - 8 * (fq & 1)) + bj * HALF) = q; } } }
    }
};
struct EpiDown {
    static constexpr bool PERM = true, HAS_PREP = false;
    bf16_t* O; int ldc; float* ssq; bf16_t* KR; const float* rope;
    __device__ __forceinline__ void operator()(const f32x4 (&acc)[2][2][4][2], const Unit& u, int wr, int wc, int fr, int fq, const LAS unsigned char* xl) const {
        const int row0 = u.pm * BM + wr * 64 + fr, col0 = u.pn * BM + wc * 32 + 8 * fq;
        const bool kr = (u.pn == 2) && (wc == 0);
#pragma unroll
        for (int ai = 0; ai < 2; ++ai)
#pragma unroll
            for (int m = 0; m < 4; ++m) { const int row = row0 + ai * HALF + m * 16; bf16_t* rowp = O + (size_t)row * ldc + col0;
#pragma unroll
                for (int bj = 0; bj < 2; ++bj) { const f32x4 v0 = acc[ai][bj][m][0], v1 = acc[ai][bj][m][1];
                    u32x4 w; w.x = pk2(v0[0], v0[1]); w.y = pk2(v0[2], v0[3]); w.z = pk2(v1[0], v1[1]); w.w = pk2(v1[2], v1[3]);
                    *(u32x4*)(rowp + bj * HALF) = w;
                    float sq = ((v0[0] * v0[0] + v0[1] * v0[1]) + (v0[2] * v0[2] + v0[3] * v0[3])) + ((v1[0] * v1[0] + v1[1] * v1[1]) + (v1[2] * v1[2] + v1[3] * v1[3]));
                    sq += __shfl_xor(sq, 16); sq += __shfl_xor(sq, 32);
                    if (fq == 0) ssq[(size_t)row * 24 + u.pn * 8 + bj * 4 + wc] = sq;
                    if (bj == 1 && kr) { const f32x4 cs0 = *(const f32x4*)(rope + (size_t)row * 32 + 8 * fq), cs1 = *(const f32x4*)(rope + (size_t)row * 32 + 8 * fq + 4);
                        u32x4 k; k.x = pk2(v0[0] * cs0[0] - v0[1] * cs0[1], v0[1] * cs0[0] + v0[0] * cs0[1]); k.y = pk2(v0[2] * cs0[2] - v0[3] * cs0[3], v0[3] * cs0[2] + v0[2] * cs0[3]);
                        k.z = pk2(v1[0] * cs1[0] - v1[1] * cs1[1], v1[1] * cs1[0] + v1[0] * cs1[1]); k.w = pk2(v1[2] * cs1[2] - v1[3] * cs1[3], v1[3] * cs1[2] + v1[2] * cs1[3]);
                        *(u32x4*)(KR + (size_t)row * 32 + 8 * fq) = k; } } }
    }
};
struct EpiBf16KV {
    static constexpr bool PERM = true, HAS_PREP = true;
    bf16_t* O; int ldc; const float* ssq;
    __device__ __forceinline__ void prep(LAS unsigned char* xl, const Unit& u, int tid) const { rstd_prep_g<24, 12, 4, KVL>(ssq, u.pm, tid, xl); }
    __device__ __forceinline__ void operator()(const f32x4 (&acc)[2][2][4][2], const Unit& u, int wr, int wc, int fr, int fq, const LAS unsigned char* xl) const {
        const int row0 = u.pm * BM + wr * 64 + fr, col0 = u.pn * BM + wc * 32 + 8 * fq;
#pragma unroll
        for (int ai = 0; ai < 2; ++ai)
#pragma unroll
            for (int m = 0; m < 4; ++m) { bf16_t* rowp = O + (size_t)(row0 + ai * HALF + m * 16) * ldc + col0; const float sc = ((const LAS float*)xl)[wr * 64 + ai * HALF + m * 16 + fr];
#pragma unroll
                for (int bj = 0; bj < 2; ++bj) { const f32x4 v0 = acc[ai][bj][m][0] * sc, v1 = acc[ai][bj][m][1] * sc;
                    u32x4 w; w.x = pk2(v0[0], v0[1]); w.y = pk2(v0[2], v0[3]); w.z = pk2(v1[0], v1[1]); w.w = pk2(v1[2], v1[3]);
                    *(u32x4*)(rowp + bj * HALF) = w; } }
    }
};
struct EpiQRope {
    static constexpr bool PERM = true, HAS_PREP = true;
    bf16_t* O; int ldc; const float* rope; const float* ssq;
    __device__ __forceinline__ void prep(LAS unsigned char* xl, const Unit& u, int tid) const { rstd_prep_g<24, 0, 6, QL>(ssq, u.pm, tid, xl); }
    __device__ __forceinline__ void operator()(const f32x4 (&acc)[2][2][4][2], const Unit& u, int wr, int wc, int fr, int fq, const LAS unsigned char* xl) const {
        const int row0 = u.pm * BM + wr * 64 + fr, col0 = u.pn * BM + wc * 32 + 8 * fq;
        const int ch0 = (u.pn * 8 + wc) % 3;
        const bool rp0 = (ch0 == 2), rp1 = (ch0 == 1), anyr = rp0 || rp1;
#pragma unroll
        for (int ai = 0; ai < 2; ++ai) {
            f32x4 cs0[4], cs1[4];
            if (anyr) {
#pragma unroll
                for (int m = 0; m < 4; ++m) { const float* rp = rope + (size_t)(row0 + ai * HALF + m * 16) * 32 + 8 * fq; cs0[m] = *(const f32x4*)rp; cs1[m] = *(const f32x4*)(rp + 4); }
            }
#pragma unroll
            for (int m = 0; m < 4; ++m) { const int row = row0 + ai * HALF + m * 16; bf16_t* rowp = O + (size_t)row * ldc + col0;
                const float qsc = ((const LAS float*)xl)[wr * 64 + ai * HALF + m * 16 + fr] * QSCALE_MLA;
#pragma unroll
                for (int bj = 0; bj < 2; ++bj) { f32x4 v0 = acc[ai][bj][m][0], v1 = acc[ai][bj][m][1];
                    if (bj == 0 ? rp0 : rp1) {
                        f32x4 r0, r1;
                        r0[0] = v0[0] * cs0[m][0] - v0[1] * cs0[m][1]; r0[1] = v0[1] * cs0[m][0] + v0[0] * cs0[m][1];
                        r0[2] = v0[2] * cs0[m][2] - v0[3] * cs0[m][3]; r0[3] = v0[3] * cs0[m][2] + v0[2] * cs0[m][3];
                        r1[0] = v1[0] * cs1[m][0] - v1[1] * cs1[m][1]; r1[1] = v1[1] * cs1[m][0] + v1[0] * cs1[m][1];
                        r1[2] = v1[2] * cs1[m][2] - v1[3] * cs1[m][3]; r1[3] = v1[3] * cs1[m][2] + v1[2] * cs1[m][3];
                        v0 = r0; v1 = r1; }
                    v0 = v0 * qsc; v1 = v1 * qsc;
                    u32x4 w; w.x = pk2(v0[0], v0[1]); w.y = pk2(v0[2], v0[3]); w.z = pk2(v1[0], v1[1]); w.w = pk2(v1[2], v1[3]);
                    *(u32x4*)(rowp + bj * HALF) = w; } }
            asm volatile("" ::: "memory");
        }
    }
};
struct EpiKVQ {
    static constexpr bool PERM = true, HAS_PREP = true;
    unsigned char* O; int ldc; const float* rope; float isc; const float* ssq;
    __device__ __forceinline__ void prep(LAS unsigned char* xl, const Unit& u, int tid) const { rstd_prep(ssq, u.pm, tid, xl); }
    __device__ __forceinline__ void operator()(const f32x4 (&acc)[2][2][4][2], const Unit& u, int wr, int wc, int fr, int fq, const LAS unsigned char* xl) const {
        const int row0 = u.pm * BM + wr * 64 + fr, col0 = u.pn * BM + wc * 32 + 8 * fq;
        const bool isv = (u.pn >= 12 && u.pn < 24);
        const bool ropew = (!isv) && ((wc & 1) == 0);
        const float sc = isc;
        const LAS float* rt = (const LAS float*)xl;
        const int part = u.pn / 12, gbr = (u.pn % 12) >> 2, ldil = 2 * gbr;
        const int blk0 = ((part * 3 + gbr) * BATCH) * 16 + 4 * (u.pn & 3) + (wc >> 1), dcol = 32 * (wc & 1) + 8 * fq;
        u32x2 wprev[2] = {}; unsigned char* rowprev = O;
#pragma unroll
        for (int ai = 0; ai < 2; ++ai) {
            f32x4 cs0[4], cs1[4];
            if (ropew) {
#pragma unroll
                for (int m = 0; m < 4; ++m) { const float* rp = rope + (size_t)(row0 + ai * HALF + m * 16) * 16 + 8 * (fq & 1); cs0[m] = *(const f32x4*)rp; cs1[m] = *(const f32x4*)(rp + 4); }
            }
#pragma unroll
            for (int m = 0; m < 4; ++m) { const int row = row0 + ai * HALF + m * 16;
                const int tt = row & (SEQ - 1), rho = ((tt & ((1 << ldil) - 1)) << (11 - ldil)) + (tt >> ldil);
                unsigned char* rowp = O + ((size_t)(blk0 + (row >> 11) * 16) * SEQ + rho) * 64 + dcol;
                const float rsc = rt[wr * 64 + ai * HALF + m * 16 + fr] * sc;
#pragma unroll
                for (int bj = 0; bj < 2; ++bj) { f32x4 v0 = acc[ai][bj][m][0], v1 = acc[ai][bj][m][1];
                    if (ropew) {
                        f32x4 r0, r1;
                        r0[0] = v0[0] * cs0[m][0] - v0[1] * cs0[m][1]; r0[1] = v0[1] * cs0[m][0] + v0[0] * cs0[m][1];
                        r0[2] = v0[2] * cs0[m][2] - v0[3] * cs0[m][3]; r0[3] = v0[3] * cs0[m][2] + v0[2] * cs0[m][3];
                        r1[0] = v1[0] * cs1[m][0] - v1[1] * cs1[m][1]; r1[1] = v1[1] * cs1[m][0] + v1[0] * cs1[m][1];
                        r1[2] = v1[2] * cs1[m][2] - v1[3] * cs1[m][3]; r1[3] = v1[3] * cs1[m][2] + v1[2] * cs1[m][3];
                        if (fq < 2) { v0 = r0; v1 = r1; } }
                    v0 = v0 * rsc; v1 = v1 * rsc;
                    u32x2 w; w.x = pk4f8(fclamp8(v0[0]), fclamp8(v0[1]), fclamp8(v0[2]), fclamp8(v0[3])); w.y = pk4f8(fclamp8(v1[0]), fclamp8(v1[1]), fclamp8(v1[2]), fclamp8(v1[3]));
                    if ((m & 1) == 0) wprev[bj] = w;
                    else { const auto r0 = __builtin_amdgcn_permlane16_swap(wprev[bj].x, w.x, false, false), r1 = __builtin_amdgcn_permlane16_swap(wprev[bj].y, w.y, false, false);
                        const u32x4 q = {r0[0], r1[0], r0[1], r1[1]};
                        unsigned char* rp = (fq & 1) ? rowp : rowprev;
                        *(u32x4*)(rp - 8 * (fq & 1) + (size_t)bj * 2 * SEQ * 64) = q; } }
                if ((m & 1) == 0) rowprev = rowp; }
            asm volatile("" ::: "memory");
        }
    }
};
template <int MODE, bool BASEF32, bool BSC = false, long BDELTA = 0> struct EpiResidB {
    static constexpr bool PERM = true, HAS_PREP = false;
    const void* base; bf16_t* hb; int ldc; unsigned char* cp8; float* ssq; float asc;
    __device__ __forceinline__ void operator()(const f32x4 (&acc)[2][2][4][2], const Unit& u, int wr, int wc, int fr, int fq, const LAS unsigned char* xl) const {
        const int row0 = u.pm * BM + wr * 64 + fr, col0 = u.pn * BM + wc * 32 + 8 * fq;
        f32x4 nb0 = {}, nb1 = {}; u32x4 nbb = {}; float nsc = 1.0f;
        const float* bsc = (const float*)((const char*)hb + BDELTA);
        if (BSC) nsc = bsc[row0];
        { const size_t off = (size_t)row0 * ldc + col0;
          if (BASEF32) { nb0 = __builtin_nontemporal_load((const f32x4*)((const float*)base + off)); nb1 = __builtin_nontemporal_load((const f32x4*)((const float*)base + off + 4)); } else nbb = *(const u32x4*)((const bf16_t*)base + off); }
        float sq = 0.f;
#pragma unroll
        for (int st = 0; st < 16; ++st) { const int ai = st >> 3, m = (st >> 1) & 3, bj = st & 1;
            const int row = row0 + ai * HALF + m * 16; const size_t off = (size_t)row * ldc + col0 + bj * HALF;
            f32x4 b0, b1;
            if (BASEF32) { b0 = nb0; b1 = nb1; } else { b0 = (f32x4){bflo(nbb.x), bfhi(nbb.x), bflo(nbb.y), bfhi(nbb.y)}; b1 = (f32x4){bflo(nbb.z), bfhi(nbb.z), bflo(nbb.w), bfhi(nbb.w)}; }
            if (BSC) { b0 = b0 * nsc; b1 = b1 * nsc; }
            if (st + 1 < 16) { const int s2 = st + 1, ai2 = s2 >> 3, m2 = (s2 >> 1) & 3, bj2 = s2 & 1; const size_t off2 = (size_t)(row0 + ai2 * HALF + m2 * 16) * ldc + col0 + bj2 * HALF;
                if (BASEF32) { nb0 = __builtin_nontemporal_load((const f32x4*)((const float*)base + off2)); nb1 = __builtin_nontemporal_load((const f32x4*)((const float*)base + off2 + 4)); } else nbb = *(const u32x4*)((const bf16_t*)base + off2);
                if (BSC && bj2 == 0) nsc = bsc[row0 + ai2 * HALF + m2 * 16];
                asm volatile("" ::: "memory"); }
            if (bj == 0) sq = 0.f;
            const f32x4 v0 = b0 + acc[ai][bj][m][0] * asc, v1 = b1 + acc[ai][bj][m][1] * asc;
            { u32x4 w; w.x = pk2(v0[0], v0[1]); w.y = pk2(v0[2], v0[3]); w.z = pk2(v1[0], v1[1]); w.w = pk2(v1[2], v1[3]); *(u32x4*)(hb + off) = w; }
            if (MODE != 0) sq += ((v0[0] * v0[0] + v0[1] * v0[1]) + (v0[2] * v0[2] + v0[3] * v0[3])) + ((v1[0] * v1[0] + v1[1] * v1[1]) + (v1[2] * v1[2] + v1[3] * v1[3]));
            if (MODE == 2) { u32x2 w; w.x = pk4f8(fclamp8(v0[0]), fclamp8(v0[1]), fclamp8(v0[2]), fclamp8(v0[3])); w.y = pk4f8(fclamp8(v1[0]), fclamp8(v1[1]), fclamp8(v1[2]), fclamp8(v1[3])); *(u32x2*)(cp8 + off) = w; }
            if (MODE != 0 && bj == 1) { sq += __shfl_xor(sq, 16); sq += __shfl_xor(sq, 32); if (fq == 0) ssq[(size_t)row * 16 + u.pn * 4 + wc] = sq; } }
    }
};
template <bool F8OUT> struct EpiSwiGLU {
    static constexpr bool PERM = true, HAS_PREP = true;
    bf16_t* O; int ldh; const float* ssq; float osc;
    __device__ __forceinline__ void prep(LAS unsigned char* xl, const Unit& u, int tid) const { rstd_prep(ssq, u.pm, tid, xl); }
    __device__ __forceinline__ void operator()(const f32x4 (&acc)[2][2][4][2], const Unit& u, int wr, int wc, int fr, int fq, const LAS unsigned char* xl) const {
        const int row0 = u.pm * BM + wr * 64 + fr, col0 = u.pn * HALF + wc * 32 + 8 * fq;
#pragma unroll
        for (int ai = 0; ai < 2; ++ai)
#pragma unroll
            for (int m = 0; m < 4; ++m) { const int row = row0 + ai * HALF + m * 16; bf16_t* rowp = O + (size_t)row * ldh + col0;
                const float rstd = ((const LAS float*)xl)[wr * 64 + ai * HALF + m * 16 + fr];
                float hv[8]; const float ge = -rstd * LOG2E, us = rstd * rstd;
#pragma unroll
                for (int n = 0; n < 2; ++n) { const f32x4 ag = acc[ai][0][m][n], au = acc[ai][1][m][n], tt = ag * ge; f32x4 den, rc;
#pragma unroll
                    for (int i = 0; i < 4; ++i) den[i] = __builtin_amdgcn_exp2f(tt[i]);
                    den = den + 1.0f;
#pragma unroll
                    for (int i = 0; i < 4; ++i) rc[i] = __builtin_amdgcn_rcpf(den[i]);
                    const f32x4 pv = (ag * (au * us)) * rc;
#pragma unroll
                    for (int i = 0; i < 4; ++i) hv[n * 4 + i] = pv[i]; }
                if constexpr (F8OUT) { u32x2 w;
                    w.x = pk4f8(__builtin_amdgcn_fmed3f(hv[0] * osc, -448.f, 448.f), __builtin_amdgcn_fmed3f(hv[1] * osc, -448.f, 448.f), __builtin_amdgcn_fmed3f(hv[2] * osc, -448.f, 448.f), __builtin_amdgcn_fmed3f(hv[3] * osc, -448.f, 448.f));
                    w.y = pk4f8(__builtin_amdgcn_fmed3f(hv[4] * osc, -448.f, 448.f), __builtin_amdgcn_fmed3f(hv[5] * osc, -448.f, 448.f), __builtin_amdgcn_fmed3f(hv[6] * osc, -448.f, 448.f), __builtin_amdgcn_fmed3f(hv[7] * osc, -448.f, 448.f));
                    *(u32x2*)((unsigned char*)O + (size_t)row * ldh + col0) = w; }
                else { u32x4 w; w.x = pk2(hv[0], hv[1]); w.y = pk2(hv[2], hv[3]); w.z = pk2(hv[4], hv[5]); w.w = pk2(hv[6], hv[7]);
                    *(u32x4*)rowp = w; } }
    }
};

template <bool NORM> struct EpiSwiGLU8 {
    static constexpr bool PERM = true, HAS_PREP = NORM;
    unsigned char* O; int ldh; float isc, osc; const float* ssq;
    __device__ __forceinline__ void prep(LAS unsigned char* xl, const Unit& u, int tid) const { rstd_prep(ssq, u.pm, tid, xl); }
    __device__ __forceinline__ void operator()(const f32x4 (&acc)[2][2][4][2], const Unit& u, int wr, int wc, int fr, int fq, const LAS unsigned char* xl) const {
        const int row0 = u.pm * BM + wr * 64 + fr, col0 = u.pn * HALF + wc * 32 + 8 * fq;
        u32x2 wprev = {0u, 0u};
#pragma unroll
        for (int ai = 0; ai < 2; ++ai)
#pragma unroll
            for (int m = 0; m < 4; ++m) {
                const float rs = NORM ? ((const LAS float*)xl)[wr * 64 + ai * HALF + m * 16 + fr] * isc : isc;
                const float ge = -rs * LOG2E, us = rs * rs * osc;
                f32x4 hv[2];
#pragma unroll
                for (int n = 0; n < 2; ++n) { const f32x4 ag = acc[ai][0][m][n], au = acc[ai][1][m][n], tt = ag * ge; f32x4 den, rc;
#pragma unroll
                    for (int i = 0; i < 4; ++i) den[i] = __builtin_amdgcn_exp2f(tt[i]);
                    den = den + 1.0f;
#pragma unroll
                    for (int i = 0; i < 4; ++i) rc[i] = __builtin_amdgcn_rcpf(den[i]);
                    const f32x4 pv = (ag * (au * us)) * rc;
#pragma unroll
                    for (int i = 0; i < 4; ++i) hv[n][i] = __builtin_amdgcn_fmed3f(pv[i], -448.f, 448.f); }
                u32x2 w; w.x = pk4f8(hv[0][0], hv[0][1], hv[0][2], hv[0][3]); w.y = pk4f8(hv[1][0], hv[1][1], hv[1][2], hv[1][3]);
                if ((m & 1) == 0) wprev = w;
                else { const auto r0 = __builtin_amdgcn_permlane16_swap(wprev.x, w.x, false, false), r1 = __builtin_amdgcn_permlane16_swap(wprev.y, w.y, false, false);
                    const u32x4 q = {r0[0], r1[0], r0[1], r1[1]};
                    *(u32x4*)(O + (size_t)(row0 + ai * HALF + (m - 1 + (fq & 1)) * 16) * ldh + (col0 - 8 * (fq & 1))) = q; } }
    }
};

template <bool FP8, class Epi, class Sched>
__device__ __forceinline__ void gemm_phase(LAS unsigned char* lds, const Gemm g, const Sched& S, const Epi& E) {
    const int tid = threadIdx.x, wid = __builtin_amdgcn_readfirstlane(tid >> 6), lane = tid & 63, wr = wid >> 2, wc = wid & 3, fr = lane & 15, fq = lane >> 4;
    int nt = g.kb / (BK * 2); asm volatile("" : "+s"(nt));
    unsigned voffA[2], voffB[2];
#pragma unroll
    for (int i = 0; i < 2; ++i) { int R, C; stage_rc(tid * 16 + i * 8192, R, C); const int Rb = Epi::PERM ? ((R & ~31) + perm32(R & 31)) : R;
        voffA[i] = (unsigned)(R * g.lda + C * 2); voffB[i] = (unsigned)(Rb * g.ldb + C * 2); }
    const size_t kstep = (size_t)(BK * 2);
    const size_t hstepA = (size_t)HALF * g.lda, hstepB = (size_t)HALF * g.ldb;
    const size_t tstepA = 2 * hstepA, tstepB = 2 * hstepB;
    const unsigned ldsw = (unsigned)wid * 1024u;
    const int aoff = lds_byte(wr * 64 + fr, fq * 8), boff = lds_byte(wc * 32 + fr, fq * 8);
#define PG8_SA(b, h) (((b) * 2 + (h)) * HTB)
#define PG8_SB(b, h) ((4 + (b) * 2 + (h)) * HTB)
#define PG8_STAGE(bufoff, gbase, voff) do { _Pragma("unroll") for (int _i = 0; _i < 2; ++_i) \
        __builtin_amdgcn_global_load_lds((const unsigned*)((const char*)(gbase) + (voff)[_i]), (LAS unsigned*)(lds + (bufoff) + ldsw + _i * 8192), 16, 0, 0); } while (0)
#define PG8_LD8(p) __builtin_shufflevector(*(const LAS v4i_t*)(p), *(const LAS v4i_t*)((p) + 1024), 0, 1, 2, 3, 4, 5, 6, 7)
#define PG8_LDA(dst, b, h) do { _Pragma("unroll") for (int m = 0; m < 4; ++m) dst[m] = PG8_LD8(lds + PG8_SA(b, h) + aoff + m * 2048); } while (0)
#define PG8_LDB(dst, b, h) do { _Pragma("unroll") for (int n = 0; n < 2; ++n) dst[n] = PG8_LD8(lds + PG8_SB(b, h) + boff + n * 2048); } while (0)
#define PG8_LO(x) __builtin_bit_cast(bf16x8, __builtin_shufflevector((x), (x), 0, 1, 2, 3))
#define PG8_HI(x) __builtin_bit_cast(bf16x8, __builtin_shufflevector((x), (x), 4, 5, 6, 7))
#define PG8_MMA(ai, bj, At, Bt) do { __builtin_amdgcn_s_setprio(1); \
        if constexpr (FP8) { _Pragma("unroll") for (int m = 0; m < 4; ++m) _Pragma("unroll") for (int n = 0; n < 2; ++n) \
            asm volatile("v_mfma_f32_16x16x128_f8f6f4 %0, %1, %2, %0" : "+v"(acc[ai][bj][m][n]) : "v"(Bt[n]), "v"(At[m])); } \
        else { _Pragma("unroll") for (int m = 0; m < 4; ++m) _Pragma("unroll") for (int n = 0; n < 2; ++n) { \
            acc[ai][bj][m][n] = __builtin_amdgcn_mfma_f32_16x16x32_bf16(PG8_LO(Bt[n]), PG8_LO(At[m]), acc[ai][bj][m][n], 0, 0, 0); \
            acc[ai][bj][m][n] = __builtin_amdgcn_mfma_f32_16x16x32_bf16(PG8_HI(Bt[n]), PG8_HI(At[m]), acc[ai][bj][m][n], 0, 0, 0); } } \
        __builtin_amdgcn_s_setprio(0); } while (0)
#define PG8_WAIT_V(n) asm volatile("s_waitcnt vmcnt(" #n ")" ::: "memory")
#define PG8_WAIT_L(n) asm volatile("s_waitcnt lgkmcnt(" #n ")" ::: "memory")
#define PG8_BAR __builtin_amdgcn_s_barrier()
#define PG8_SCHED __builtin_amdgcn_sched_barrier(0)
    Unit cur, nxt; int ui = 0, prep_pm = -1;
    if (!S.next(0, cur)) return;
    f32x4 acc[2][2][4][2];
#pragma unroll
    for (int a = 0; a < 2; ++a)
#pragma unroll
        for (int b = 0; b < 2; ++b)
#pragma unroll
            for (int m = 0; m < 4; ++m)
#pragma unroll
                for (int n = 0; n < 2; ++n) acc[a][b][m][n] = (f32x4){0.f, 0.f, 0.f, 0.f};
    v8i_t At[4], B0[2], B1[2];
    const char* cA = (const char*)g.A + (size_t)cur.pm * tstepA + (size_t)cur.ks * g.kso; const char* cB = (const char*)g.Bt + (size_t)cur.e * g.bgs + (size_t)cur.pn * tstepB + (size_t)cur.ks * g.kso;
    PG8_STAGE(PG8_SB(0, 0), cB, voffB); PG8_STAGE(PG8_SB(0, 1), cB + hstepB, voffB); PG8_STAGE(PG8_SA(0, 0), cA, voffA); PG8_STAGE(PG8_SA(0, 1), cA + hstepA, voffA);
    if (wr == 1) PG8_BAR;
    PG8_WAIT_V(2); PG8_BAR;
    PG8_STAGE(PG8_SB(1, 0), cB + kstep, voffB); PG8_STAGE(PG8_SA(1, 0), cA + kstep, voffA); PG8_STAGE(PG8_SB(1, 1), cB + hstepB + kstep, voffB);
    PG8_WAIT_V(6); PG8_BAR;
    for (;;) {
        const bool has_next = S.next(ui + 1, nxt);
        const char* nA = has_next ? (const char*)g.A + (size_t)nxt.pm * tstepA + (size_t)nxt.ks * g.kso : cA; const char* nB = has_next ? (const char*)g.Bt + (size_t)nxt.e * g.bgs + (size_t)nxt.pn * tstepB + (size_t)nxt.ks * g.kso : cB;
#pragma unroll 1
        for (int t = 0; t < nt; t += 2) {
            const bool last = (t == nt - 2);
            const char* a1 = cA + (size_t)(t + 1) * kstep;
            const char* a2 = last ? nA : cA + (size_t)(t + 2) * kstep; const char* b2 = last ? nB : cB + (size_t)(t + 2) * kstep;
            const char* a3 = a2 + kstep; const char* b3 = b2 + kstep;
            PG8_LDB(B0, 0, 0); PG8_LDB(B1, 0, 1); PG8_SCHED; PG8_LDA(At, 0, 0); PG8_STAGE(PG8_SA(1, 1), a1 + hstepA, voffA);
            PG8_WAIT_V(8); PG8_WAIT_L(0); PG8_BAR; PG8_MMA(0, 0, At, B0); PG8_MMA(0, 1, At, B1); PG8_BAR; PG8_SCHED;
            PG8_LDA(At, 0, 1); PG8_STAGE(PG8_SB(0, 0), b2, voffB); PG8_STAGE(PG8_SB(0, 1), b2 + hstepB, voffB); PG8_STAGE(PG8_SA(0, 0), a2, voffA);
            PG8_WAIT_V(8); PG8_WAIT_L(0); PG8_BAR; PG8_MMA(1, 0, At, B0); PG8_MMA(1, 1, At, B1); PG8_BAR; PG8_SCHED;
            PG8_LDB(B0, 1, 0); PG8_LDB(B1, 1, 1); PG8_SCHED; PG8_LDA(At, 1, 0); PG8_STAGE(PG8_SA(0, 1), a2 + hstepA, voffA);
            PG8_WAIT_V(8); PG8_WAIT_L(0); PG8_BAR; PG8_MMA(0, 0, At, B0); PG8_MMA(0, 1, At, B1); PG8_BAR; PG8_SCHED;
            PG8_LDA(At, 1, 1); PG8_STAGE(PG8_SB(1, 0), b3, voffB); PG8_STAGE(PG8_SB(1, 1), b3 + hstepB, voffB); PG8_STAGE(PG8_SA(1, 0), a3, voffA);
            PG8_WAIT_V(8); PG8_WAIT_L(0); PG8_BAR; PG8_MMA(1, 0, At, B0); PG8_MMA(1, 1, At, B1); PG8_BAR; PG8_SCHED;
        }
        if (wr == 0) PG8_BAR;
        if constexpr (Epi::HAS_PREP) { if (cur.pm != prep_pm) { E.prep(lds + STAGE_BYTES, cur, tid); prep_pm = cur.pm; } }
        if constexpr (FP8) { asm volatile("s_nop 15\n\ts_nop 7" ::: "memory"); PG8_SCHED; }
        E(acc, cur, wr, wc, fr, fq, lds + STAGE_BYTES);
        if (!has_next) break;
#pragma unroll
        for (int a = 0; a < 2; ++a)
#pragma unroll
            for (int b = 0; b < 2; ++b)
#pragma unroll
                for (int m = 0; m < 4; ++m)
#pragma unroll
                    for (int n = 0; n < 2; ++n) acc[a][b][m][n] = (f32x4){0.f, 0.f, 0.f, 0.f};
        cur = nxt; cA = nA; cB = nB; ++ui;
        if (wr == 1) PG8_BAR;
    }
    PG8_WAIT_V(0);
    PG8_BAR;
#undef PG8_SA
#undef PG8_SB
#undef PG8_STAGE
#undef PG8_LDA
#undef PG8_LDB
#undef PG8_MMA
#undef PG8_LO
#undef PG8_HI
#undef PG8_LD8
#undef PG8_WAIT_V
#undef PG8_WAIT_L
#undef PG8_BAR
#undef PG8_SCHED
}
}

namespace att {
struct Unit {
    const bf16_t* q;  long qs;
    const bf16_t* k1; long k1s;
    const bf16_t* k2; long k2s;
    const bf16_t* v;  long vs;
    bf16_t* o; long os;
    float* lse; long lses;
    int q0, kt0, W;
};
__device__ __forceinline__ int crow(int r, int hi) { return (r & 3) + 8 * (r >> 2) + 4 * hi; }
typedef short v4i16_t __attribute__((ext_vector_type(4)));
__device__ __forceinline__ s16x4 vtr(const LAS unsigned char* p) { return __builtin_bit_cast(s16x4, __builtin_amdgcn_ds_read_tr16_b64_v4i16((LAS v4i16_t*)p)); }

constexpr bool ATT_F8O = true; constexpr float ATT_OSC = 16.0f, OM_SC = 16.0f;
template <int DQK, int NGRP> struct Geo {
    static constexpr int WPG = 8 / NGRP, GT = 64 * WPG, KSTR = DQK * 2 + 16, KB = 64 * KSTR, VB = 8192, GRP_BYTES = 2 * KB + 2 * VB, KN = 512 / GT;
};

template <int DQK, int NGRP, bool HAS_LSE>
__device__ __forceinline__ void attn_units(LAS unsigned char* lds, const Unit& U, int nt) {
    typedef Geo<DQK, NGRP> G;
    const int tid = threadIdx.x, lane = tid & 63, r = lane & 31, h = lane >> 5;
    const int wave = __builtin_amdgcn_readfirstlane(tid >> 6), grp = wave / G::WPG, wg = wave % G::WPG, tg = tid - grp * G::GT;
    LAS unsigned char* gl = lds + grp * G::GRP_BYTES;
    const int qlo = U.q0 + 32 * wg, qhi = qlo + 31, qpos = qlo + r;
    bf16x8 qf[DQK / 16];
    { const bf16_t* qp = U.q + (long)qpos * U.qs + 8 * h;
#pragma unroll
      for (int d0 = 0; d0 < DQK / 16; ++d0) qf[d0] = *(const bf16x8*)(qp + 16 * d0); }
    u32x4 rk[G::KN], rv[G::KN], rk2;
    rk2 = (u32x4){0u, 0u, 0u, 0u};
#define ATT_LOAD(t) do { const int kb_ = U.kt0 + 64 * (t); \
        _Pragma("unroll") for (int i_ = 0; i_ < G::KN; ++i_) { const int c_ = tg + G::GT * i_, key_ = c_ >> 3, ch_ = c_ & 7; int p_ = kb_ + key_; p_ = p_ < 0 ? 0 : p_; \
            rk[i_] = *(const u32x4*)(U.k1 + (long)p_ * U.k1s + ch_ * 8); rv[i_] = *(const u32x4*)(U.v + (long)p_ * U.vs + ch_ * 8); } \
        if (DQK == 96) { if (tg < 256) { const int key_ = tg >> 2, ch_ = tg & 3; int p_ = kb_ + key_; p_ = p_ < 0 ? 0 : p_; rk2 = *(const u32x4*)(U.k2 + (long)p_ * U.k2s + ch_ * 8); } } } while (0)
#define ATT_WRITE(buf) do { LAS unsigned char* kb_ = gl + (buf) * G::KB; LAS unsigned char* vb_ = gl + 2 * G::KB + (buf) * G::VB; \
        _Pragma("unroll") for (int i_ = 0; i_ < G::KN; ++i_) { const int c_ = tg + G::GT * i_, key_ = c_ >> 3, ch_ = c_ & 7; \
            *(LAS u32x4*)(kb_ + key_ * G::KSTR + ch_ * 16) = rk[i_]; *(LAS u32x4*)(vb_ + (ch_ >> 2) * 4096 + key_ * 64 + (ch_ & 3) * 16) = rv[i_]; } \
        if (DQK == 96) { if (tg < 256) { const int key_ = tg >> 2, ch_ = tg & 3; *(LAS u32x4*)(kb_ + key_ * G::KSTR + 128 + ch_ * 16) = rk2; } } } while (0)
    constexpr float ATT_THR = 6.0f;
    float m_run = 0.f; bool fresh = true;
    f32x16 o0 = {}, o1 = {}, negm = {};
    float l_run = 0.f;
    f32x16 maskR;
#pragma unroll
    for (int i = 0; i < 16; ++i) maskR[i] = (crow(i, h) <= r) ? 0.f : -INFINITY;
    const int trow = ((lane & 15) >> 2), tcol = ((lane >> 4) & 1) * 32 + (lane & 3) * 8;
    ATT_LOAD(0); ATT_WRITE(0);
    __syncthreads();
    for (int t = 0; t < nt; ++t) {
        if (t + 1 < nt) ATT_LOAD(t + 1);
        const LAS unsigned char* Kb = gl + (t & 1) * G::KB; const LAS unsigned char* Vb = gl + 2 * G::KB + (t & 1) * G::VB;
        const int kb = U.kt0 + 64 * t;
        if (!(kb > qhi || kb + 63 < qlo - U.W || kb + 63 < 0)) {
            f32x16 s0 = negm, s1 = negm;
            if (kb + 63 > qlo) { if (kb == qlo) { s0 = negm + maskR; s1 = negm - INFINITY; } else s1 = negm + maskR; }
            const LAS unsigned char* kp = Kb + r * G::KSTR + 16 * h;
#pragma unroll
            for (int d0 = 0; d0 < DQK / 16; ++d0) { const bf16x8 kf0 = *(const LAS bf16x8*)(kp + 32 * d0), kf1 = *(const LAS bf16x8*)(kp + 32 * G::KSTR + 32 * d0);
                s0 = __builtin_amdgcn_mfma_f32_32x32x16_bf16(kf0, qf[d0], s0, 0, 0, 0); s1 = __builtin_amdgcn_mfma_f32_32x32x16_bf16(kf1, qf[d0], s1, 0, 0, 0); }
            float mx = fmaxf(fmaxf(s0[0], s0[1]), s0[2]), my = fmaxf(fmaxf(s1[0], s1[1]), s1[2]);
#pragma unroll
            for (int i = 3; i < 15; i += 2) { mx = fmaxf(fmaxf(mx, s0[i]), s0[i + 1]); my = fmaxf(fmaxf(my, s1[i]), s1[i + 1]); }
            mx = fmaxf(fmaxf(mx, s0[15]), fmaxf(my, s1[15]));
            { auto rr = __builtin_amdgcn_permlane32_swap(__float_as_uint(mx), __float_as_uint(mx), false, false); mx = fmaxf(__uint_as_float(rr[0]), __uint_as_float(rr[1])); }
            float dl = fresh ? mx : ((mx > ATT_THR) ? mx : 0.f);
            dl = (dl == -INFINITY) ? 0.f : dl;
            if (__any(dl != 0.f)) {
                m_run += dl; const float alpha = __builtin_amdgcn_exp2f(-dl);
#pragma unroll
                for (int i = 0; i < 16; ++i) { s0[i] -= dl; s1[i] -= dl; o0[i] *= alpha; o1[i] *= alpha; negm[i] = -m_run; }
                l_run *= alpha;
            }
            fresh = false;
#pragma unroll
            for (int i = 0; i < 16; ++i) { s0[i] = __builtin_amdgcn_exp2f(s0[i]); s1[i] = __builtin_amdgcn_exp2f(s1[i]); }
            { f32x2 a2 = {0.f, 0.f};
#pragma unroll
              for (int i = 0; i < 16; i += 2) a2 += (f32x2){s0[i], s0[i + 1]} + (f32x2){s1[i], s1[i + 1]};
              l_run += a2[0] + a2[1]; }
            bf16x8 pf[4];
#pragma unroll
            for (int s2 = 0; s2 < 2; ++s2) { u32x4 w; w.x = pk2(s0[8 * s2], s0[8 * s2 + 1]); w.y = pk2(s0[8 * s2 + 2], s0[8 * s2 + 3]); w.z = pk2(s0[8 * s2 + 4], s0[8 * s2 + 5]); w.w = pk2(s0[8 * s2 + 6], s0[8 * s2 + 7]);
                pf[s2] = __builtin_bit_cast(bf16x8, w);
                u32x4 x; x.x = pk2(s1[8 * s2], s1[8 * s2 + 1]); x.y = pk2(s1[8 * s2 + 2], s1[8 * s2 + 3]); x.z = pk2(s1[8 * s2 + 4], s1[8 * s2 + 5]); x.w = pk2(s1[8 * s2 + 6], s1[8 * s2 + 7]);
                pf[2 + s2] = __builtin_bit_cast(bf16x8, x); }
#pragma unroll
            for (int s2 = 0; s2 < 4; ++s2) {
                const LAS unsigned char* vp = Vb + (16 * s2 + 4 * h + trow) * 64 + tcol;
                const s16x4 a0 = vtr(vp), a1 = vtr(vp + 8 * 64), b0 = vtr(vp + 4096), b1 = vtr(vp + 4096 + 8 * 64);
                const bf16x8 vf0 = (bf16x8){a0[0], a0[1], a0[2], a0[3], a1[0], a1[1], a1[2], a1[3]};
                const bf16x8 vf1 = (bf16x8){b0[0], b0[1], b0[2], b0[3], b1[0], b1[1], b1[2], b1[3]};
                o0 = __builtin_amdgcn_mfma_f32_32x32x16_bf16(vf0, pf[s2], o0, 0, 0, 0);
                o1 = __builtin_amdgcn_mfma_f32_32x32x16_bf16(vf1, pf[s2], o1, 0, 0, 0);
            }
        }
        if (t + 1 < nt) ATT_WRITE((t + 1) & 1);
        __syncthreads();
    }
#undef ATT_LOAD
#undef ATT_WRITE
    float l_tot; { auto rr = __builtin_amdgcn_permlane32_swap(__float_as_uint(l_run), __float_as_uint(l_run), false, false); l_tot = __uint_as_float(rr[0]) + __uint_as_float(rr[1]); }
    const float inv = 1.0f / l_tot;
    if constexpr (ATT_F8O) {
        const float is = inv * ATT_OSC; unsigned char* op = (unsigned char*)U.o + (long)qpos * U.os + 16 * h;
        unsigned w0[4], w1[4];
#pragma unroll
        for (int g4 = 0; g4 < 4; ++g4) {
            w0[g4] = pk4f8(fclamp8(o0[4 * g4] * is), fclamp8(o0[4 * g4 + 1] * is), fclamp8(o0[4 * g4 + 2] * is), fclamp8(o0[4 * g4 + 3] * is));
            w1[g4] = pk4f8(fclamp8(o1[4 * g4] * is), fclamp8(o1[4 * g4 + 1] * is), fclamp8(o1[4 * g4 + 2] * is), fclamp8(o1[4 * g4 + 3] * is)); }
        const auto a0 = __builtin_amdgcn_permlane32_swap(w0[0], w0[2], false, false), a1 = __builtin_amdgcn_permlane32_swap(w0[1], w0[3], false, false);
        const auto b0 = __builtin_amdgcn_permlane32_swap(w1[0], w1[2], false, false), b1 = __builtin_amdgcn_permlane32_swap(w1[1], w1[3], false, false);
        *(u32x4*)op = (u32x4){a0[0], a0[1], a1[0], a1[1]};
        *(u32x4*)(op + 32) = (u32x4){b0[0], b0[1], b1[0], b1[1]};
    } else {
    bf16_t* op = U.o + (long)qpos * U.os + 4 * h;
#pragma unroll
    for (int g4 = 0; g4 < 4; ++g4) {
        u32x2 w0, w1;
        w0.x = pk2(o0[4 * g4] * inv, o0[4 * g4 + 1] * inv); w0.y = pk2(o0[4 * g4 + 2] * inv, o0[4 * g4 + 3] * inv);
        w1.x = pk2(o1[4 * g4] * inv, o1[4 * g4 + 1] * inv); w1.y = pk2(o1[4 * g4 + 2] * inv, o1[4 * g4 + 3] * inv);
        *(u32x2*)(op + 8 * g4) = w0; *(u32x2*)(op + 32 + 8 * g4) = w1;
    }
    }
    if (HAS_LSE) { if (h == 0) U.lse[(long)qpos * U.lses] = m_run + log2f(l_tot); }
}

constexpr int DSW_KSTR = 144, DSW_KB = 256 * DSW_KSTR, DSW_VB = 4 * 8192, DSW_GRP = DSW_KB + DSW_VB;
struct DswTensors { const unsigned char* KVQ; unsigned char* OG; float* LSE; };
struct DswUnit { const unsigned char* q; const unsigned char* k; const unsigned char* v; long st; unsigned char* o; long os; float* lse; long lses; int q0, kt0, slot; bool ldprev; };
__device__ __forceinline__ u32x4 f8x8_bf16(unsigned lo, unsigned hi, float sc) {
    const f32x2 a = __builtin_amdgcn_cvt_pk_f32_fp8(lo, false), b = __builtin_amdgcn_cvt_pk_f32_fp8(lo, true), c = __builtin_amdgcn_cvt_pk_f32_fp8(hi, false), d = __builtin_amdgcn_cvt_pk_f32_fp8(hi, true);
    u32x4 w; w.x = pk2(a.x * sc, a.y * sc); w.y = pk2(b.x * sc, b.y * sc); w.z = pk2(c.x * sc, c.y * sc); w.w = pk2(d.x * sc, d.y * sc); return w;
}
__device__ __forceinline__ void dsw_unit(int s, int grp, bool first, const DswTensors& T, DswUnit& U) {
    const int bgh = s >> 3, b = bgh / 48, gbr = (bgh / 16) % 3, hh = bgh & 15, ju = 8 * grp + (s & 7);
    const int dil = gbr == 0 ? 1 : (gbr == 1 ? 4 : 16);
    const int rr = gbr == 0 ? 0 : (gbr == 1 ? (ju >> 2) : ju), nb = gbr == 0 ? ju : (gbr == 1 ? (ju & 3) : 0);
    const size_t rowb = (size_t)b * SEQ + rr;
    { const size_t part = (size_t)3 * BATCH * 16 * SEQ * 64, blk = ((size_t)((gbr * BATCH + b) * 16 + hh) * SEQ + (size_t)rr * (SEQ / dil)) * 64;
      U.k = T.KVQ + blk; U.v = U.k + part; U.q = U.k + 2 * part; U.st = 64; }
    U.o = T.OG + (size_t)gbr * M * D + rowb * D + hh * 64; U.os = (long)dil * D;
    U.lse = T.LSE + (size_t)gbr * M * 16 + rowb * 16 + hh; U.lses = (long)dil * 16;
    U.q0 = 128 * nb; U.kt0 = 128 * (nb - 1);
    U.slot = nb & 1; U.ldprev = (nb > 0) && (first || (s & 7) == 0);
}
struct DswRegs { u32x4 rk[4], rv[4]; u32x2 qn[4]; int q0, kt0, slot; bool ldprev; unsigned char* o; long os; float* lse; long lses; };
struct DswCur { bf16x8 qf[4]; int q0, kt0, slot; unsigned char* o; long os; float* lse; long lses; };
__device__ __forceinline__ void dsw_load(DswRegs& R, int s, int grp, bool first, const DswTensors& T, int tg, int wg, int r, int h) {
    DswUnit U; dsw_unit(s, grp, first, T, U);
#pragma unroll
    for (int i = 0; i < 2; ++i) { const int key = (tg >> 2) + 64 * i, ch = tg & 3; const int p = U.q0 + key;
        R.rk[i] = __builtin_nontemporal_load((const u32x4*)(U.k + (long)p * U.st + ch * 16)); R.rv[i] = __builtin_nontemporal_load((const u32x4*)(U.v + (long)p * U.st + ch * 16)); }
    if (U.ldprev) {
#pragma unroll
        for (int i = 0; i < 2; ++i) { const int key = (tg >> 2) + 64 * i, ch = tg & 3; const int p = U.kt0 + key;
            R.rk[2 + i] = *(const u32x4*)(U.k + (long)p * U.st + ch * 16); R.rv[2 + i] = *(const u32x4*)(U.v + (long)p * U.st + ch * 16); }
    }
    const unsigned char* qp = U.q + (long)(U.q0 + 32 * wg + r) * U.st + 8 * h;
#pragma unroll
    for (int d0 = 0; d0 < 4; ++d0) R.qn[d0] = __builtin_nontemporal_load((const u32x2*)(qp + 16 * d0));
    R.q0 = U.q0; R.kt0 = U.kt0; R.slot = U.slot; R.ldprev = U.ldprev; R.o = U.o; R.os = U.os; R.lse = U.lse; R.lses = U.lses;
}
__device__ __forceinline__ void dsw_stage(const DswRegs& R, DswCur& C, LAS unsigned char* Kb, LAS unsigned char* Vb, int tg) {
#pragma unroll
    for (int i = 0; i < 2; ++i) { const int key = (tg >> 2) + 64 * i, ch = tg & 3;
        LAS u32x4* kd = (LAS u32x4*)(Kb + (R.slot * 128 + key) * DSW_KSTR + ch * 32); kd[0] = f8x8_bf16(R.rk[i].x, R.rk[i].y, 1.0f); kd[1] = f8x8_bf16(R.rk[i].z, R.rk[i].w, 1.0f);
        LAS u32x4* vd = (LAS u32x4*)(Vb + (R.slot * 2 + i) * 8192 + (ch >> 1) * 4096 + (key & 63) * 64 + (ch & 1) * 32); vd[0] = f8x8_bf16(R.rv[i].x, R.rv[i].y, 1.0f); vd[1] = f8x8_bf16(R.rv[i].z, R.rv[i].w, 1.0f); }
    if (R.ldprev) {
#pragma unroll
        for (int i = 0; i < 2; ++i) { const int key = (tg >> 2) + 64 * i, ch = tg & 3; const int ps = R.slot ^ 1;
            LAS u32x4* kd = (LAS u32x4*)(Kb + (ps * 128 + key) * DSW_KSTR + ch * 32); kd[0] = f8x8_bf16(R.rk[2 + i].x, R.rk[2 + i].y, 1.0f); kd[1] = f8x8_bf16(R.rk[2 + i].z, R.rk[2 + i].w, 1.0f);
            LAS u32x4* vd = (LAS u32x4*)(Vb + (ps * 2 + i) * 8192 + (ch >> 1) * 4096 + (key & 63) * 64 + (ch & 1) * 32); vd[0] = f8x8_bf16(R.rv[2 + i].x, R.rv[2 + i].y, 1.0f); vd[1] = f8x8_bf16(R.rv[2 + i].z, R.rv[2 + i].w, 1.0f); }
    }
#pragma unroll
    for (int d0 = 0; d0 < 4; ++d0) C.qf[d0] = __builtin_bit_cast(bf16x8, f8x8_bf16(R.qn[d0].x, R.qn[d0].y, QSCALE_DSW));
    C.q0 = R.q0; C.kt0 = R.kt0; C.slot = R.slot; C.o = R.o; C.os = R.os; C.lse = R.lse; C.lses = R.lses;
}
__device__ __forceinline__ void dsw_compute(const DswCur& C, const LAS unsigned char* Kb, const LAS unsigned char* Vb, int wg, int r, int h, int trow, int tcol, const f32x16& maskL, const f32x16& maskR) {
    const int q0 = C.q0, kt0 = C.kt0;
    const int qlo = q0 + 32 * wg, qhi = qlo + 31, qpos = qlo + r;
    constexpr float DSW_THR = 6.0f;
    float m_run = 0.f; bool fresh = true;
    f32x16 o0 = {}, o1 = {}, negm = {};
    float l_run = 0.f;
#pragma unroll 1
    for (int sub = 0; sub < 8; ++sub) {
        const int kb = kt0 + 32 * sub;
        if (kb > qhi || kb + 31 < qlo - 128 || kb + 31 < 0) continue;
        f32x16 sc = negm;
        if (sub == wg) sc = negm + maskL; else if (sub == wg + 4) sc = negm + maskR;
        const int half = (sub < 4) ? (C.slot ^ 1) : C.slot;
        const LAS unsigned char* kp = Kb + (128 * half + 32 * (sub & 3) + r) * DSW_KSTR + 16 * h;
#pragma unroll
        for (int d0 = 0; d0 < 4; ++d0) { const bf16x8 kf = *(const LAS bf16x8*)(kp + 32 * d0); sc = __builtin_amdgcn_mfma_f32_32x32x16_bf16(kf, C.qf[d0], sc, 0, 0, 0); }
        float mx = fmaxf(fmaxf(sc[0], sc[1]), sc[2]), my = fmaxf(fmaxf(sc[3], sc[4]), sc[5]);
#pragma unroll
        for (int i = 6; i < 14; i += 4) { mx = fmaxf(fmaxf(mx, sc[i]), sc[i + 1]); my = fmaxf(fmaxf(my, sc[i + 2]), sc[i + 3]); }
        mx = fmaxf(fmaxf(mx, sc[14]), fmaxf(my, sc[15]));
        { auto rr = __builtin_amdgcn_permlane32_swap(__float_as_uint(mx), __float_as_uint(mx), false, false); mx = fmaxf(__uint_as_float(rr[0]), __uint_as_float(rr[1])); }
        float dl = fresh ? mx : ((mx > DSW_THR) ? mx : 0.f);
        dl = (dl == -INFINITY) ? 0.f : dl;
        if (__any(dl != 0.f)) {
            m_run += dl; const float alpha = __builtin_amdgcn_exp2f(-dl);
#pragma unroll
            for (int i = 0; i < 16; ++i) { sc[i] -= dl; o0[i] *= alpha; o1[i] *= alpha; negm[i] = -m_run; }
            l_run *= alpha;
        }
        fresh = false;
#pragma unroll
        for (int i = 0; i < 16; ++i) sc[i] = __builtin_amdgcn_exp2f(sc[i]);
        { f32x2 a2 = {0.f, 0.f};
#pragma unroll
          for (int i = 0; i < 16; i += 4) a2 += (f32x2){sc[i], sc[i + 1]} + (f32x2){sc[i + 2], sc[i + 3]};
          l_run += a2[0] + a2[1]; }
        bf16x8 pf[2];
#pragma unroll
        for (int s2 = 0; s2 < 2; ++s2) { u32x4 w; w.x = pk2(sc[8 * s2], sc[8 * s2 + 1]); w.y = pk2(sc[8 * s2 + 2], sc[8 * s2 + 3]); w.z = pk2(sc[8 * s2 + 4], sc[8 * s2 + 5]); w.w = pk2(sc[8 * s2 + 6], sc[8 * s2 + 7]);
            pf[s2] = __builtin_bit_cast(bf16x8, w); }
#pragma unroll
        for (int s2 = 0; s2 < 2; ++s2) {
            const LAS unsigned char* vp = Vb + (2 * half + ((sub >> 1) & 1)) * 8192 + (32 * (sub & 1) + 16 * s2 + 4 * h + trow) * 64 + tcol;
            const s16x4 a0 = vtr(vp), a1 = vtr(vp + 8 * 64), b0 = vtr(vp + 4096), b1 = vtr(vp + 4096 + 8 * 64);
            const bf16x8 vf0 = (bf16x8){a0[0], a0[1], a0[2], a0[3], a1[0], a1[1], a1[2], a1[3]};
            const bf16x8 vf1 = (bf16x8){b0[0], b0[1], b0[2], b0[3], b1[0], b1[1], b1[2], b1[3]};
            o0 = __builtin_amdgcn_mfma_f32_32x32x16_bf16(vf0, pf[s2], o0, 0, 0, 0);
            o1 = __builtin_amdgcn_mfma_f32_32x32x16_bf16(vf1, pf[s2], o1, 0, 0, 0);
        }
    }
    float l_tot; { auto rr = __builtin_amdgcn_permlane32_swap(__float_as_uint(l_run), __float_as_uint(l_run), false, false); l_tot = __uint_as_float(rr[0]) + __uint_as_float(rr[1]); }
    const float inv = 1.0f / l_tot;
    unsigned char* op = C.o + (long)qpos * C.os + 16 * h;
    {
        unsigned w0[4], w1[4];
#pragma unroll
        for (int g4 = 0; g4 < 4; ++g4) { w0[g4] = pk4f8(o0[4 * g4] * inv, o0[4 * g4 + 1] * inv, o0[4 * g4 + 2] * inv, o0[4 * g4 + 3] * inv); w1[g4] = pk4f8(o1[4 * g4] * inv, o1[4 * g4 + 1] * inv, o1[4 * g4 + 2] * inv, o1[4 * g4 + 3] * inv); }
        const auto a0 = __builtin_amdgcn_permlane32_swap(w0[0], w0[2], false, false), a1 = __builtin_amdgcn_permlane32_swap(w0[1], w0[3], false, false);
        const auto b0 = __builtin_amdgcn_permlane32_swap(w1[0], w1[2], false, false), b1 = __builtin_amdgcn_permlane32_swap(w1[1], w1[3], false, false);
        *(u32x4*)op = (u32x4){a0[0], a0[1], a1[0], a1[1]};
        *(u32x4*)(op + 32) = (u32x4){b0[0], b0[1], b1[0], b1[1]};
    }
    if (h == 0) C.lse[(long)qpos * C.lses] = m_run + log2f(l_tot);
}
__device__ __forceinline__ void dsw_phase(LAS unsigned char* lds, const DswTensors& T, int vcu, int G) {
    const int tid = threadIdx.x, lane = tid & 63, r = lane & 31, h = lane >> 5;
    const int wave = __builtin_amdgcn_readfirstlane(tid >> 6), grp = wave >> 2, wg = wave & 3, tg = tid & 255;
    LAS unsigned char* Kb = lds + grp * DSW_GRP; LAS unsigned char* Vb = Kb + DSW_KB;
    const int nv = (256 - vcu + G - 1) / G, nst = 12 * nv;
    const int trow = ((lane & 15) >> 2), tcol = ((lane >> 4) & 1) * 32 + (lane & 3) * 8;
    DswRegs A, B; DswCur C;
    f32x16 maskL, maskR;
#pragma unroll
    for (int i = 0; i < 16; ++i) { const int c = crow(i, h); maskL[i] = (c >= r) ? 0.f : -INFINITY; maskR[i] = (c <= r) ? 0.f : -INFINITY; }
#define DSW_STEP(i_) ((vcu + ((i_) / 12) * G) * 12 + (i_) % 12)
#define DSW_FIRST(i_) (((i_) % 12) == 0)
    if (nst > 0) { dsw_load(A, DSW_STEP(0), grp, DSW_FIRST(0), T, tg, wg, r, h); dsw_load(B, DSW_STEP(1), grp, DSW_FIRST(1), T, tg, wg, r, h); }
    for (int st = 0; st < nst; st += 2) {
        dsw_stage(A, C, Kb, Vb, tg);
        __syncthreads();
        if (st + 2 < nst) dsw_load(A, DSW_STEP(st + 2), grp, DSW_FIRST(st + 2), T, tg, wg, r, h);
        dsw_compute(C, Kb, Vb, wg, r, h, trow, tcol, maskL, maskR);
        __syncthreads();
        dsw_stage(B, C, Kb, Vb, tg);
        __syncthreads();
        if (st + 3 < nst) dsw_load(B, DSW_STEP(st + 3), grp, DSW_FIRST(st + 3), T, tg, wg, r, h);
        dsw_compute(C, Kb, Vb, wg, r, h, trow, tcol, maskL, maskR);
        __syncthreads();
    }
#undef DSW_STEP
#undef DSW_FIRST
}
}

constexpr size_t MiB = 1u << 20;
constexpr size_t WS_CTL = 0, CTL_ZERO_BYTES = 65536;
constexpr size_t WS_ROPEA = 1 * MiB, WS_ROPEB = 3 * MiB, WS_MISC = 4 * MiB;
constexpr size_t MISC_RG = 0, MISC_TOKE = 64 * 1024, MISC_TOKG = 192 * 1024, MISC_TOKS = 320 * 1024, MISC_CNT = 448 * 1024, MISC_TILEE = 512 * 1024, MISC_NT = 520 * 1024, MISC_INV0 = 576 * 1024;
constexpr size_t WS_WD = 5 * MiB, WS_WUQ = WS_WD + 1536 * 1024, WS_WUKV = WS_WUQ + 1152 * 1024, WS_WO = WS_WUKV + 1 * MiB, WS_WGU = WS_WO + 2 * MiB, WS_WDN = WS_WGU + 11 * MiB,
                 WS_WKVQ = WS_WDN + 5632 * 1024, WS_WO2 = WS_WKVQ + 18 * MiB, WS_WEND = WS_WO2 + 2 * MiB;
static_assert(WS_WEND <= 48 * MiB, "weights region");
constexpr size_t WS_XN = 48 * MiB;
constexpr size_t WS_DOWN = 80 * MiB, WS_CQ = 104 * MiB, WS_CKV = 116 * MiB, WS_KR = 124 * MiB, WS_Q = 128 * MiB, WS_KV = 176 * MiB, WS_O = 240 * MiB;
constexpr size_t WS_HID = 80 * MiB;
constexpr size_t WS_KVQ = 80 * MiB, WS_OG = 224 * MiB, WS_LSE = 320 * MiB;
constexpr size_t WS_WGUE = 324 * MiB, WS_WDNE = 380 * MiB, WS_SSQ1 = 408 * MiB, WS_SSQ2 = 409 * MiB, WS_X8 = 410 * MiB, WS_OM = 426 * MiB, WS_END = 458 * MiB;
constexpr size_t WS_HN3 = 80 * MiB, WS_XG = 96 * MiB, WS_YB = 130 * MiB, WS_HIDE = 198 * MiB, WS_YT = 96 * MiB;
static_assert(WS_HIDE + (size_t)RMAX * EF <= WS_WGUE && WS_XG + (size_t)RMAX * D <= WS_YB && WS_YB + (size_t)RMAX * D * 2 <= WS_HIDE && WS_WGUE + (size_t)NE * EGU_N * D <= WS_WDNE && WS_WDNE + (size_t)NE * D * EF <= WS_SSQ1 && WS_HN3 + (size_t)M * D <= WS_XG
              && WS_KVQ + (size_t)M * KVQ_N <= WS_OG && WS_OG + (size_t)3 * M * D * 2 <= WS_LSE && WS_LSE + (size_t)3 * M * 16 * 4 <= WS_WGUE && WS_O + (size_t)M * D * 2 <= WS_WGUE, "workspace map");
constexpr int P12_ROWS_OFF = 40960;
constexpr int P15_MAIN = 128, P15_NS = 7, YT_ROWS = RMAX - P15_MAIN * 256;
constexpr float WSC1 = 32.0f, WSC2 = 64.0f, HSC = 4.0f, YSC = 16.0f;
constexpr int CW_TMO = 0, CW_RDY = 64, CW_BAR = 4096;

constexpr int RING_BYTES = 131072, LDS_BYTES = 147456, LDSCTL_OFF = LDS_BYTES - 1024, MISC_OFF = LDSCTL_OFF + 320;
constexpr int SCR_OFF = 36864, SCR_WAVE = 8704;

#define XB_TMO      128
#define XB_XCNT(j)  (256  + 64 * (j))
#define XB_XSUB(j)  (1280 + 64 * (j))
#define XB_XGEN(j)  (2304 + 64 * (j))
#define XB_TOP      3328
#define XB_TOPGEN   3392
#define XCD_BAR_WORDS 3456
#define XB_LSUB(j)  (3456 + 64 * (j))
#define XB_LGEN(j)  (4480 + 64 * (j))
#define XB_SPIN_CAP (1u << 18)
__device__ __forceinline__ unsigned xb_ld(unsigned* p)              { return __hip_atomic_load(p, __ATOMIC_RELAXED, __HIP_MEMORY_SCOPE_AGENT); }
__device__ __forceinline__ unsigned xb_add(unsigned* p, unsigned v) { return __hip_atomic_fetch_add(p, v, __ATOMIC_RELAXED, __HIP_MEMORY_SCOPE_AGENT); }
__device__ __forceinline__ unsigned xb_xcc_id() { return (unsigned)__builtin_amdgcn_s_getreg((3 << 11) | 20) & 0xFu; }
#define XB_SPIN(cond, bar) do { unsigned _sp = 0; while (cond) { __builtin_amdgcn_s_sleep(1); \
    if ((++_sp & 255u) == 0u) { if (xb_ld(&(bar)[XB_TMO])) break; if (_sp > XB_SPIN_CAP) { atomicAdd(&(bar)[XB_TMO], 1u); break; } } } } while (0)
struct XcdBarrier { unsigned* bar; unsigned x; volatile LAS unsigned* st; };
__device__ __forceinline__ XcdBarrier xcd_barrier_post(unsigned* bar, volatile LAS unsigned* st) {
    XcdBarrier b; b.bar = bar; b.x = xb_xcc_id(); b.st = st;
    if (threadIdx.x == 0) st[2] = xb_add(&bar[XB_XCNT(b.x)], 1u);
    return b;
}
__device__ __forceinline__ void xcd_barrier_complete(unsigned* bar, unsigned x, unsigned& nloc, unsigned& nx) {
    const unsigned G = gridDim.x * gridDim.y * gridDim.z;
    unsigned sum, cnt, mine, sp = 0u;
    for (;;) {
        sum = 0u; cnt = 0u; mine = 0u;
#pragma unroll
        for (unsigned j = 0; j < 16; ++j) { const unsigned c = xb_ld(&bar[XB_XCNT(j)]); sum += c; cnt += (c > 0u) ? 1u : 0u; mine = (j == x) ? c : mine; }
        if (sum == G) break;
        __builtin_amdgcn_s_sleep(1);
        if ((++sp & 255u) == 0u) { if (xb_ld(&bar[XB_TMO])) break; if (sp > XB_SPIN_CAP) { atomicAdd(&bar[XB_TMO], 1u); break; } }
    }
    nloc = mine > 0u ? mine : 1u; nx = cnt > 0u ? cnt : 1u;
}
__device__ __forceinline__ unsigned xcd_even_index(unsigned* bar, unsigned x) {
    unsigned ok = (gridDim.x * gridDim.y * gridDim.z == 256u) ? 1u : 0u, xi = 0u, cnt = 0u;
#pragma unroll
    for (unsigned j = 0; j < 16; ++j) { const unsigned c = xb_ld(&bar[XB_XCNT(j)]); if (c != 0u && c != 32u) ok = 0u; cnt += (c > 0u) ? 1u : 0u; xi += (j < x && c > 0u) ? 1u : 0u; }
    return (ok != 0u && cnt == 8u) ? 1u + xi : 0u;
}
__device__ __forceinline__ void xcd_barrier(const XcdBarrier& b) {
    asm volatile("s_waitcnt vmcnt(0)" ::: "memory");
    __syncthreads();
    if (threadIdx.x == 0) {
        unsigned* bar = b.bar;
        __builtin_amdgcn_s_waitcnt(0);
        unsigned nloc = b.st[0], nx = b.st[1];
        if (nloc == 0u) { xcd_barrier_complete(bar, b.x, nloc, nx); b.st[0] = nloc; b.st[1] = nx; b.st[3] = xcd_even_index(bar, b.x); }
        const unsigned old = xb_add(&bar[XB_XSUB(b.x)], 1u);
        const unsigned gen = old / nloc;
        if (old + 1u == (gen + 1u) * nloc) {
            __builtin_amdgcn_fence(__ATOMIC_RELEASE, "agent");
            asm volatile("s_waitcnt vmcnt(0)" ::: "memory");
            const unsigned og = xb_add(&bar[XB_TOP], 1u);
            const unsigned tg = og / nx;
            if (og + 1u == (tg + 1u) * nx) xb_add(&bar[XB_TOPGEN], 1u);
            else XB_SPIN(xb_ld(&bar[XB_TOPGEN]) == tg, bar);
            __builtin_amdgcn_fence(__ATOMIC_ACQUIRE, "agent");
            xb_add(&bar[XB_XGEN(b.x)], 1u);
            asm volatile("s_waitcnt vmcnt(0)" ::: "memory");
        } else {
            XB_SPIN(xb_ld(&bar[XB_XGEN(b.x)]) == gen, bar);
            __builtin_amdgcn_fence(__ATOMIC_ACQUIRE, "agent");
            asm volatile("s_waitcnt vmcnt(0)" ::: "memory");
        }
    }
    __syncthreads();
}

__device__ __forceinline__ void xcd_barrier_local(const XcdBarrier& b) {
    asm volatile("s_waitcnt vmcnt(0)" ::: "memory");
    __syncthreads();
    if (threadIdx.x == 0) {
        unsigned* bar = b.bar;
        __builtin_amdgcn_s_waitcnt(0);
        const unsigned old = xb_add(&bar[XB_LSUB(b.x)], 1u), gen = old >> 5;
        if ((old & 31u) == 31u) xb_add(&bar[XB_LGEN(b.x)], 1u);
        else XB_SPIN(xb_ld(&bar[XB_LGEN(b.x)]) == gen, bar);
        __builtin_amdgcn_fence(__ATOMIC_ACQUIRE, "agent");
        asm volatile("s_waitcnt vmcnt(0)" ::: "memory");
    }
    __syncthreads();
}

__device__ __forceinline__ int dmap(int mode, int n) {
    switch (mode) {
        default: return n;
        case 1: { if (n < 640) return n; const int i = n - 640; return 640 + (i < 16 ? 2 * i : 2 * (i - 16) + 1); }
        case 2: { const int hh = n / 96, d = n - 96 * hh; if (d < 64) return n; const int i = d - 64; return 96 * hh + 64 + (i < 16 ? 2 * i : 2 * (i - 16) + 1); }
        case 3: return (n >> 7) * 256 + (n & 127);
        case 4: { const int d = n & 63; if (d >= 16) return n; return (n - d) + (d < 8 ? 2 * d : 2 * (d - 8) + 1); }
        case 5: { if (n >= 3072) return n; const int d = n & 63; if (d >= 16) return n; return (n - d) + (d < 8 ? 2 * d : 2 * (d - 8) + 1); }
    }
}
template <bool F8>
__device__ __forceinline__ void tr_item(const float* W, int K, int N, const float* gain, float wsc, void* WT, int mode, int row_off, int item, int lane) {
    const int nblk = N >> 5, kb = item / nblk, nb = item - kb * nblk, k0 = 128 * kb, n0 = 32 * nb;
    const int n4 = lane & 7, kc = lane >> 3;
    const float* src = W + (size_t)(k0 + 16 * kc) * N + n0 + 4 * n4;
    f32x4 v[16];
#pragma unroll
    for (int kk = 0; kk < 16; ++kk) v[kk] = __builtin_nontemporal_load((const f32x4*)(src + (size_t)kk * N));
    float gv[16];
#pragma unroll
    for (int q = 0; q < 4; ++q) { const f32x4 g4 = gain ? *(const f32x4*)(gain + k0 + 16 * kc + 4 * q) : (f32x4){1.f, 1.f, 1.f, 1.f}; gv[4 * q] = g4[0] * wsc; gv[4 * q + 1] = g4[1] * wsc; gv[4 * q + 2] = g4[2] * wsc; gv[4 * q + 3] = g4[3] * wsc; }
#pragma unroll
    for (int j = 0; j < 4; ++j) {
        const size_t n = (size_t)(dmap(mode, n0 + 4 * n4 + j) + row_off);
        if (F8) { u32x4 o;
#pragma unroll
            for (int q = 0; q < 4; ++q) o[q] = pk4f8(fclamp8(v[4 * q][j] * gv[4 * q]), fclamp8(v[4 * q + 1][j] * gv[4 * q + 1]), fclamp8(v[4 * q + 2][j] * gv[4 * q + 2]), fclamp8(v[4 * q + 3][j] * gv[4 * q + 3]));
            *(u32x4*)((unsigned char*)WT + n * K + k0 + 16 * kc) = o; }
        else { u32x4 o0, o1;
#pragma unroll
            for (int q = 0; q < 4; ++q) { o0[q] = pk2(v[2 * q][j] * gv[2 * q], v[2 * q + 1][j] * gv[2 * q + 1]); o1[q] = pk2(v[8 + 2 * q][j] * gv[8 + 2 * q], v[9 + 2 * q][j] * gv[9 + 2 * q]); }
            u32x4* dst = (u32x4*)((bf16_t*)WT + n * K + k0 + 16 * kc); dst[0] = o0; dst[1] = o1; }
    }
}
constexpr int I_E = (D / 128) * (EF / 32), I_ED = (EF / 128) * (D / 32), MOE_ITEMS = NE * (2 * I_E + I_ED);
__device__ __forceinline__ void moe_conv_item(int it, const float* wg, const float* wu, const float* wd, const float* gain, unsigned char* WGUE, unsigned char* WDNE, int lane) {
    const int e = it / (2 * I_E + I_ED), r = it % (2 * I_E + I_ED);
    if (r < I_E) tr_item<true>(wg + (size_t)e * D * EF, D, EF, gain, WSC1, WGUE + (size_t)e * EGU_N * D, 3, 0, r, lane);
    else if (r < 2 * I_E) tr_item<true>(wu + (size_t)e * D * EF, D, EF, gain, WSC1, WGUE + (size_t)e * EGU_N * D, 3, 128, r - I_E, lane);
    else tr_item<true>(wd + (size_t)e * EF * D, EF, D, nullptr, WSC2, WDNE + (size_t)e * D * EF, 0, 0, r - 2 * I_E, lane);
}
__device__ __forceinline__ void row_rms_to_bf16(const float* xrow, bf16_t* orow, int lane, float* inv) {
    const f32x4* xr = (const f32x4*)xrow + lane;
    f32x4 v[4]; float s = 0.f;
#pragma unroll
    for (int j = 0; j < 4; ++j) { v[j] = __builtin_nontemporal_load(xr + 64 * j); s += (v[j].x * v[j].x + v[j].y * v[j].y) + (v[j].z * v[j].z + v[j].w * v[j].w); }
    const float nrm = sqrtf(wave_sum(s) * (1.f / D) + RMS_EPS), rstd = 1.0f / nrm;
    if (lane == 0) *inv = nrm;
    u32x2* o8 = (u32x2*)orow + lane;
#pragma unroll
    for (int j = 0; j < 4; ++j) { u32x2 w; w.x = pk2(v[j].x * rstd, v[j].y * rstd); w.y = pk2(v[j].z * rstd, v[j].w * rstd); o8[64 * j] = w; }
}

__device__ __forceinline__ void row_rms_to_fp8(const float* xrow, unsigned char* orow, int lane) {
    const f32x4* xr = (const f32x4*)xrow + lane;
    f32x4 v[4]; float s = 0.f;
#pragma unroll
    for (int j = 0; j < 4; ++j) { v[j] = xr[64 * j]; s += (v[j].x * v[j].x + v[j].y * v[j].y) + (v[j].z * v[j].z + v[j].w * v[j].w); }
    const float rstd = 1.0f / sqrtf(wave_sum(s) * (1.f / D) + RMS_EPS);
    unsigned* o4 = (unsigned*)orow + lane;
#pragma unroll
    for (int j = 0; j < 4; ++j) { const f32x4 t = v[j] * rstd; o4[64 * j] = pk4f8(fclamp8(t.x), fclamp8(t.y), fclamp8(t.z), fclamp8(t.w)); }
}
constexpr int NWAVES = 8, NPHASE = 17;
struct Args { const float* in[22]; const int* pos; float* out; unsigned char* ws; int ph_lo, ph_hi; };

__global__ void __launch_bounds__(NWAVES * 64, 2) trunk_fwd(Args args) {
    extern __shared__ __attribute__((aligned(16))) unsigned char lds_raw[];
    LAS unsigned char* lds = (LAS unsigned char*)lds_raw;
    volatile LAS unsigned* MISC = (volatile LAS unsigned*)(lds + MISC_OFF);
    const int tid = threadIdx.x, lane = tid & 63, wave = __builtin_amdgcn_readfirstlane(tid >> 6);
    const int G = gridDim.x; const int bx = blockIdx.x; int vcu = (G % 8 == 0) ? (bx % 8) * (G / 8) + bx / 8 : bx;
    int gw = vcu * NWAVES + wave; const int NGW = G * NWAVES;
    int cb = bx; bool lok = false;
    unsigned char* ws = args.ws;
    unsigned* ctl = (unsigned*)(ws + WS_CTL);
    const float* x = args.in[0]; const int* positions = args.pos;
    const float* norm_attn = args.in[2]; const float* norm_ffn = args.in[3];
    const float* mla_w_down = args.in[4]; const float* mla_q_norm = args.in[5]; const float* mla_w_uq = args.in[6]; const float* mla_kv_norm = args.in[7];
    const float* mla_w_ukv = args.in[8]; const float* mla_w_o = args.in[9]; const float* dsw_kv_norm = args.in[10]; const float* dsw_w_kv = args.in[11];
    const float* dsw_w_q = args.in[12]; const float* dsw_w_o = args.in[13]; const float* ffn_w_gate = args.in[14]; const float* ffn_w_up = args.in[15];
    const float* ffn_w_down = args.in[16]; const float* moe_router = args.in[17]; const float* moe_w_gate = args.in[18]; const float* moe_w_up = args.in[19];
    const float* moe_w_down = args.in[20]; const float* final_norm = args.in[21];
    float* out = args.out;
    float* ROPEA = (float*)(ws + WS_ROPEA); float* ROPEB = (float*)(ws + WS_ROPEB);
    float* RG = (float*)(ws + WS_MISC + MISC_RG); int* TOKE = (int*)(ws + WS_MISC + MISC_TOKE); float* TOKG = (float*)(ws + WS_MISC + MISC_TOKG); int* TOKS = (int*)(ws + WS_MISC + MISC_TOKS);
    float* INV0 = (float*)(ws + WS_MISC + MISC_INV0);
    unsigned* CNT = (unsigned*)(ws + WS_MISC + MISC_CNT); unsigned* TILEE = (unsigned*)(ws + WS_MISC + MISC_TILEE); unsigned* NTILES = (unsigned*)(ws + WS_MISC + MISC_NT);
    bf16_t* WD = (bf16_t*)(ws + WS_WD); bf16_t* WUQ = (bf16_t*)(ws + WS_WUQ); bf16_t* WUKV = (bf16_t*)(ws + WS_WUKV); bf16_t* WO = (bf16_t*)(ws + WS_WO); bf16_t* WGU = (bf16_t*)(ws + WS_WGU);
    bf16_t* WDN = (bf16_t*)(ws + WS_WDN); bf16_t* WKVQ = (bf16_t*)(ws + WS_WKVQ); bf16_t* WO2 = (bf16_t*)(ws + WS_WO2);
    float* SSQ1 = (float*)(ws + WS_SSQ1); float* SSQ2 = (float*)(ws + WS_SSQ2); float* SSQD = (float*)(ws + WS_CQ);
    bf16_t* XN = (bf16_t*)(ws + WS_XN); bf16_t* DOWN = (bf16_t*)(ws + WS_DOWN); bf16_t* CQ = (bf16_t*)(ws + WS_CQ); bf16_t* CKV = (bf16_t*)(ws + WS_CKV); bf16_t* KR = (bf16_t*)(ws + WS_KR);
    bf16_t* Q = (bf16_t*)(ws + WS_Q); bf16_t* KV = (bf16_t*)(ws + WS_KV); bf16_t* O = (bf16_t*)(ws + WS_O); bf16_t* HID = (bf16_t*)(ws + WS_HID);
    bf16_t* KVQ = (bf16_t*)(ws + WS_KVQ); bf16_t* OG = (bf16_t*)(ws + WS_OG); float* LSE = (float*)(ws + WS_LSE); bf16_t* OM = (bf16_t*)(ws + WS_OM); unsigned char* X8 = ws + WS_X8;
    unsigned char* WGUE = ws + WS_WGUE; unsigned char* WDNE = ws + WS_WDNE; unsigned char* HN3 = ws + WS_HN3; unsigned char* XG = ws + WS_XG; bf16_t* YB = (bf16_t*)(ws + WS_YB); bf16_t* YT = (bf16_t*)(ws + WS_YT); unsigned char* HIDE = ws + WS_HIDE;

    for (int u = tid; u < (LDS_BYTES - LDSCTL_OFF) / 4; u += NWAVES * 64) ((LAS unsigned*)(lds + LDSCTL_OFF))[u] = 0u;
    __syncthreads();
    XcdBarrier bar; bar.bar = ctl + CW_BAR; bar.x = 0; bar.st = nullptr;
    if (!MK_PER_PHASE) bar = xcd_barrier_post(ctl + CW_BAR, MISC + 8);
    const int lo = args.ph_lo, hi = args.ph_hi;
#ifndef PH_MASK
#define PH_MASK 0x1FFFFu
#endif
#define IN(k) (lo <= (k) && (k) < hi && ((PH_MASK >> (k)) & 1u))
#ifndef REP_MASK
#define REP_MASK 0u
#endif
#ifndef REP_EXTRA
#define REP_EXTRA 1
#endif
#define REPS(k) (1 + REP_EXTRA * (int)((REP_MASK >> (k)) & 1u))
#ifndef DUP_MASK
#define DUP_MASK 0u
#endif
#define GDUP(k) (1 + REP_EXTRA * (int)((DUP_MASK >> (k)) & 1u))
#ifndef SEAM_REPS
#define SEAM_REPS 1
#endif
#define SEAM(k) do { if (IN(k) && IN((k) + 1)) { if (!MK_PER_PHASE) { for (int sr_ = 0; sr_ < SEAM_REPS; ++sr_) xcd_barrier(bar); } } } while (0)
#define SEAML(k) do { if (IN(k) && IN((k) + 1)) { if (!MK_PER_PHASE) { for (int sr_ = 0; sr_ < SEAM_REPS; ++sr_) { if (lok) xcd_barrier_local(bar); else xcd_barrier(bar); } } } } while (0)

    const bool split = (G == 256);
    constexpr int I_KVc = (D / 128) * (6144 / 32), I_Qc = (D / 128) * (3072 / 32), I_DNc = (FF / 128) * (D / 32), I_O2c = (D / 128) * (D / 32), LATE_ITEMS = I_KVc + I_Qc + I_DNc + I_O2c, MOE_EARLY = 8192, MOE_MID = 3584;
#define LATE_ITEM(r_) do { int q_ = (r_); \
        if (q_ < I_KVc) { tr_item<true>(dsw_w_kv, D, 6144, dsw_kv_norm, WSC1, WKVQ, 5, 0, q_, lane); break; } q_ -= I_KVc; \
        if (q_ < I_Qc)  { tr_item<true>(dsw_w_q, D, 3072, norm_attn + D, WSC1, WKVQ, 4, 6144, q_, lane); break; } q_ -= I_Qc; \
        if (q_ < I_DNc) { tr_item<(FFN8 != 0 || FFN8D != 0)>(ffn_w_down, FF, D, nullptr, (FFN8 || FFN8D) ? WSC2 : 1.0f, WDN, 0, 0, q_, lane); break; } q_ -= I_DNc; \
        tr_item<true>(dsw_w_o, D, D, nullptr, WSC1, WO2, 0, 0, q_, lane); } while (0)
    if (IN(0)) for (int rep_ = 0; rep_ < REPS(0); ++rep_) {
        constexpr int I_D = (D / 128) * (672 / 32), I_UQ = (QL / 128) * (UQ_N / 32), I_UKV = (KVL / 128) * (UKV_N / 32), I_O = (D / 128) * (D / 32), I_G = (D / 128) * (FF / 32);
        constexpr int NITEMS = I_D + I_UQ + I_UKV + I_O + 2 * I_G;
        for (int it = gw; it < NITEMS + (split ? 0 : LATE_ITEMS); it += NGW) {
            int r = it;
            if (r < I_G)   { tr_item<FFN8 != 0>(ffn_w_gate, D, FF, norm_ffn, FFN8 ? WSC1 : 1.0f, WGU, 3, 0, r, lane); continue; } r -= I_G;
            if (r < I_G)   { tr_item<FFN8 != 0>(ffn_w_up, D, FF, norm_ffn, FFN8 ? WSC1 : 1.0f, WGU, 3, 128, r, lane); continue; } r -= I_G;
            if (r < I_D)   { tr_item<false>(mla_w_down, D, 672, norm_attn, 1.0f, WD, 1, 0, r, lane); continue; } r -= I_D;
            if (r < I_UQ)  { tr_item<false>(mla_w_uq, QL, UQ_N, mla_q_norm, 1.0f, WUQ, 2, 0, r, lane); continue; } r -= I_UQ;
            if (r < I_UKV) { tr_item<false>(mla_w_ukv, KVL, UKV_N, mla_kv_norm, 1.0f, WUKV, 0, 0, r, lane); continue; } r -= I_UKV;
            if (r < I_O)   { tr_item<true>(mla_w_o, D, D, nullptr, WSC1, WO, 0, 0, r, lane); continue; } r -= I_O;
            LATE_ITEM(r);
        }
        for (int i = vcu * 512 + tid; i < 96 * 128; i += G * 512) ((u32x4*)(WD + (size_t)672 * D))[i] = (u32x4){0u, 0u, 0u, 0u};
        for (int i = vcu * 512 + tid; i < M * 24; i += G * 512) {
            const int m = i / 24, j = i % 24; const float p = (float)positions[m];
            float inv; float* dst;
            if (j < 16) { inv = exp2f(-(float)j * (18.931568569324174f / 16.0f)); dst = ROPEA + (size_t)m * 32 + 2 * j; }
            else { inv = exp2f(-(float)(j - 16) * (18.931568569324174f / 8.0f)); dst = ROPEB + (size_t)m * 16 + 2 * (j - 16); }
            float sn, cs; sincosf(p * inv, &sn, &cs); dst[0] = cs; dst[1] = sn;
        }
        for (int i = vcu * 512 + tid; i < NE * D; i += G * 512) { const int e = i / D, k = i % D; RG[i] = moe_router[k * NE + e] * norm_ffn[D + k]; }
        for (int m = gw; m < M; m += NGW) row_rms_to_bf16(x + (size_t)m * D, XN + (size_t)m * D, lane, INV0 + m);
    }
    SEAM(0);
    if (!MK_PER_PHASE && IN(0) && IN(1)) { const unsigned ev = (unsigned)__builtin_amdgcn_readfirstlane(MISC[11]), rk = (unsigned)__builtin_amdgcn_readfirstlane(MISC[10]);
        if (ev != 0u && rk < 32u) { lok = true; vcu = (int)((ev - 1u) * 32u + rk); cb = (int)(rk * 8u + (ev - 1u)); gw = vcu * NWAVES + wave; } }
    if (IN(1)) for (int rep_ = 0; rep_ < REPS(1); ++rep_) {
        pg8::Gemm g{XN, WD, 2 * D, 2 * D, 2 * D, 0}; pg8::StaticOrder S; S.init(M / 256, DOWN_N / 256, G, cb, nullptr, GDUP(1));
        pg8::EpiDown E{DOWN, DOWN_N, SSQD, KR, ROPEA};
        pg8::gemm_phase<false>(lds, g, S, E);
        if (split && cb >= 192) { for (int it = (cb - 192) * NWAVES + wave; it < LATE_ITEMS; it += 64 * NWAVES) LATE_ITEM(it); }
    }
    SEAM(1);
    if (IN(3)) for (int rep_ = 0; rep_ < REPS(3); ++rep_) {
#ifndef P3SKIPA
        { pg8::Gemm g{DOWN, WUQ, 2 * QL, 2 * DOWN_N, 2 * QL, 0};   pg8::StaticOrder S; S.init(M / 256, UQ_N / 256, G, cb, nullptr, GDUP(3));
          pg8::EpiQRope E{Q, UQ_N, ROPEA, SSQD};
          pg8::gemm_phase<false>(lds, g, S, E);
          if (split && cb >= 128) { for (int it = MOE_EARLY + (cb - 128) * NWAVES + wave; it < MOE_EARLY + MOE_MID; it += 128 * NWAVES) moe_conv_item(it, moe_w_gate, moe_w_up, moe_w_down, norm_ffn + D, WGUE, WDNE, lane); } }
#endif
#ifndef P3SKIPB
        { pg8::Gemm g{DOWN + QL, WUKV, 2 * KVL, 2 * DOWN_N, 2 * KVL, 0};   pg8::StaticOrder S; S.init(M / 256, UKV_N / 256, G, cb, nullptr, GDUP(3));
          pg8::EpiBf16KV E{KV, UKV_N, SSQD};
          pg8::gemm_phase<false>(lds, g, S, E); }
#endif
    }
    SEAML(3);
    if (IN(4)) for (int rep_ = 0; rep_ < REPS(4); ++rep_) {
        for (int vid = vcu; vid < 256; vid += G) {
            const int b = vid >> 5, cset = (vid >> 3) & 3, kq = vid & 7;
#pragma unroll 1
            for (int i = 0; i < 4; ++i) {
                const int hh = 4 * i + cset, qb = (i & 1) ? 7 - kq : kq;
                att::Unit U;
                const size_t rb = (size_t)b * SEQ;
                U.q = Q + rb * UQ_N + hh * 96; U.qs = UQ_N;
                U.k1 = KV + rb * UKV_N + hh * 128; U.k1s = UKV_N; U.k2 = KR + rb * 32; U.k2s = 32;
                U.v = KV + rb * UKV_N + hh * 128 + 64; U.vs = UKV_N;
                U.o = (bf16_t*)((unsigned char*)O + rb * D + hh * 64); U.os = D; U.lse = nullptr; U.lses = 0;
                U.q0 = 256 * qb; U.kt0 = 0; U.W = 1 << 30;
                att::attn_units<96, 1, false>(lds, U, 4 * (qb + 1));
            }
        }
    }
    SEAML(4);
    if (IN(5)) for (int rep_ = 0; rep_ < REPS(5); ++rep_) {
        pg8::Gemm g{O, WO, D, D, D, 0}; pg8::StaticOrder S; S.init(M / 256, D / 256, G, cb, nullptr, GDUP(5));
        pg8::EpiResidB<1, false, true, (long)(WS_MISC + MISC_INV0) - (long)WS_XN> E{XN, XN, D, nullptr, SSQ1, 1.0f / (att::ATT_OSC * WSC1)};
        pg8::gemm_phase<true>(lds, g, S, E);
    }
    SEAML(5);
    if (IN(6) && DBG_STOP != 1) for (int rep_ = 0; rep_ < REPS(6); ++rep_) {
        pg8::StaticOrder S; S.init(M / 256, GU_N / 256, G, cb, nullptr, GDUP(6));
        if constexpr (FFN8) { pg8::Gemm g{XN, WGU, D, D, D, 0}; pg8::EpiSwiGLU8<true> E{(unsigned char*)HID, FF, 1.0f / WSC1, HSC, SSQ1}; pg8::gemm_phase<true>(lds, g, S, E); }
        else { pg8::Gemm g{XN, WGU, 2 * D, 2 * D, 2 * D, 0}; pg8::EpiSwiGLU<FFN8D != 0> E{HID, FF, SSQ1, HSC}; pg8::gemm_phase<false>(lds, g, S, E); }
        if (split && cb >= 128) { for (int it = (cb - 128) * NWAVES + wave; it < MOE_EARLY; it += 128 * NWAVES) moe_conv_item(it, moe_w_gate, moe_w_up, moe_w_down, norm_ffn + D, WGUE, WDNE, lane); }
    }
    SEAML(6);
    if (IN(7) && DBG_STOP != 1) for (int rep_ = 0; rep_ < REPS(7); ++rep_) {
        constexpr bool DN8 = (FFN8 != 0 || FFN8D != 0);
        pg8::Gemm g{HID, WDN, DN8 ? FF : 2 * FF, DN8 ? FF : 2 * FF, DN8 ? FF : 2 * FF, 0}; pg8::StaticOrder S; S.init(M / 256, D / 256, G, cb, nullptr, GDUP(7));
        pg8::EpiResidB<2, false> E{XN, XN, D, X8, SSQ2, DN8 ? 1.0f / (WSC2 * HSC) : 1.0f};
        pg8::gemm_phase<DN8>(lds, g, S, E);
    }
    SEAML(7);
    constexpr bool L1ON = (DBG_STOP == 0 || DBG_STOP >= 3);
    if (IN(8) && L1ON) for (int rep_ = 0; rep_ < REPS(8); ++rep_) {
        pg8::Gemm g{X8, WKVQ, D, D, D, 0}; pg8::StaticOrder S; S.init(M / 256, KVQ_N / 256, G, cb, nullptr, GDUP(8)); S.wgm = FP8_WGM;
        pg8::EpiKVQ E{(unsigned char*)KVQ, KVQ_N, ROPEB, 1.0f / WSC1, SSQ2};
        pg8::gemm_phase<true>(lds, g, S, E);
    }
    SEAML(8);
    if (IN(9) && L1ON) for (int rep_ = 0; rep_ < REPS(9); ++rep_) {
        const att::DswTensors T{(const unsigned char*)KVQ, (unsigned char*)OG, LSE};
        att::dsw_phase(lds, T, vcu, G);
    }
    SEAML(9);
    if (IN(10) && L1ON) for (int rep_ = 0; rep_ < REPS(10); ++rep_) {
        for (int m0 = gw; m0 < M; m0 += NGW) {
            const int m = (G == 256) ? (gw >> 8) * SEQ + (gw & 255) + 256 * (m0 >> 11) : m0;
            float l[3]; u32x4 a[3];
#pragma unroll
            for (int g3 = 0; g3 < 3; ++g3) { l[g3] = LSE[(size_t)g3 * M * 16 + (size_t)m * 16 + (lane >> 2)]; a[g3] = __builtin_nontemporal_load((const u32x4*)((const unsigned char*)OG + (size_t)g3 * M * D + (size_t)m * D + 16 * lane)); }
            const float mx = fmaxf(l[0], fmaxf(l[1], l[2]));
            float w0 = __builtin_amdgcn_exp2f(l[0] - mx), w1 = __builtin_amdgcn_exp2f(l[1] - mx), w2 = __builtin_amdgcn_exp2f(l[2] - mx);
            const float inv = att::OM_SC / (w0 + w1 + w2); w0 *= inv; w1 *= inv; w2 *= inv;
            u32x4 o8;
#pragma unroll
            for (int j = 0; j < 4; ++j) {
                const f32x2 x0 = __builtin_amdgcn_cvt_pk_f32_fp8(a[0][j], false), y0 = __builtin_amdgcn_cvt_pk_f32_fp8(a[0][j], true);
                const f32x2 x1 = __builtin_amdgcn_cvt_pk_f32_fp8(a[1][j], false), y1 = __builtin_amdgcn_cvt_pk_f32_fp8(a[1][j], true);
                const f32x2 x2 = __builtin_amdgcn_cvt_pk_f32_fp8(a[2][j], false), y2 = __builtin_amdgcn_cvt_pk_f32_fp8(a[2][j], true);
                o8[j] = pk4f8(fclamp8(w0 * x0.x + w1 * x1.x + w2 * x2.x), fclamp8(w0 * x0.y + w1 * x1.y + w2 * x2.y), fclamp8(w0 * y0.x + w1 * y1.x + w2 * y2.x), fclamp8(w0 * y0.y + w1 * y1.y + w2 * y2.y)); }
            *(u32x4*)((unsigned char*)OM + (size_t)m * D + 16 * lane) = o8;
        }
    }
    SEAML(10);
    if (IN(11) && L1ON) for (int rep_ = 0; rep_ < REPS(11); ++rep_) {
        pg8::Gemm g{OM, WO2, D, D, D, 0}; pg8::StaticOrder S; S.init(M / 256, D / 256, G, cb, nullptr, GDUP(11));
        pg8::EpiResidB<0, false> E{XN, XN, D, nullptr, nullptr, 1.0f / (att::OM_SC * WSC1)};
        pg8::gemm_phase<true>(lds, g, S, E);
    }
    SEAML(11);
    constexpr bool MOEON = (DBG_STOP == 0);
    if (IN(12) && MOEON) for (int rep_ = 0; rep_ < REPS(12); ++rep_) {
        LAS unsigned* cntl = (LAS unsigned*)(lds + 32768);
        f32x4 rw[NE][4];
#pragma unroll
        for (int e = 0; e < NE; ++e)
#pragma unroll
            for (int j = 0; j < 4; ++j) rw[e][j] = *(const f32x4*)(RG + e * D + 4 * lane + 256 * j);
        for (int vb = vcu; vb < 256; vb += G) {
            if (tid < NE) cntl[tid] = 0u;
            __syncthreads();
            u32x2 nx[4];
            { const u32x2* xr = (const u32x2*)(XN + (size_t)(vb * 64 + wave * 8) * D) + lane;
#pragma unroll
              for (int j = 0; j < 4; ++j) nx[j] = xr[64 * j]; }
            for (int i = 0; i < 8; ++i) {
                const int m = vb * 64 + wave * 8 + i;
                f32x4 v[4]; float ss = 0.f; float lg[NE];
#pragma unroll
                for (int e = 0; e < NE; ++e) lg[e] = 0.f;
#pragma unroll
                for (int j = 0; j < 4; ++j) v[j] = (f32x4){bflo(nx[j].x), bfhi(nx[j].x), bflo(nx[j].y), bfhi(nx[j].y)};
                if (i + 1 < 8) { const u32x2* xr = (const u32x2*)(XN + (size_t)(m + 1) * D) + lane;
#pragma unroll
                    for (int j = 0; j < 4; ++j) nx[j] = xr[64 * j]; }
#pragma unroll
                for (int j = 0; j < 4; ++j) { ss += (v[j].x * v[j].x + v[j].y * v[j].y) + (v[j].z * v[j].z + v[j].w * v[j].w);
#pragma unroll
                    for (int e = 0; e < NE; ++e) { const f32x4 w = rw[e][j]; lg[e] += (v[j].x * w.x + v[j].y * w.y) + (v[j].z * w.z + v[j].w * w.w); } }
                const float rstd = 1.0f / sqrtf(wave_sum(ss) * (1.f / D) + RMS_EPS);
#pragma unroll
                for (int e = 0; e < NE; ++e) lg[e] = wave_sum(lg[e]) * rstd;
                int i1 = 0; float v1 = lg[0];
#pragma unroll
                for (int e = 1; e < NE; ++e) if (lg[e] > v1) { v1 = lg[e]; i1 = e; }
                int i2 = -1; float v2 = -INFINITY;
#pragma unroll
                for (int e = 0; e < NE; ++e) if (e != i1 && lg[e] > v2) { v2 = lg[e]; i2 = e; }
                const float g1 = 1.0f / (1.0f + expf(v2 - v1)), g2 = 1.0f - g1;
                if (lane == 0) { TOKE[2 * m] = i1; TOKE[2 * m + 1] = i2; TOKG[2 * m] = g1; TOKG[2 * m + 1] = g2;
                    __hip_atomic_fetch_add(cntl + i1, 1u, __ATOMIC_RELAXED, __HIP_MEMORY_SCOPE_WORKGROUP); __hip_atomic_fetch_add(cntl + i2, 1u, __ATOMIC_RELAXED, __HIP_MEMORY_SCOPE_WORKGROUP); }
                if (split) { LAS unsigned* o4 = (LAS unsigned*)(lds + P12_ROWS_OFF + (wave * 8 + i) * D) + lane;
#pragma unroll
                    for (int j = 0; j < 4; ++j) { const f32x4 t = v[j] * rstd; o4[64 * j] = pk4f8(fclamp8(t.x), fclamp8(t.y), fclamp8(t.z), fclamp8(t.w)); } }
                else { unsigned* o4 = (unsigned*)(HN3 + (size_t)m * D) + lane;
#pragma unroll
                    for (int j = 0; j < 4; ++j) { const f32x4 t = v[j] * rstd; o4[64 * j] = pk4f8(fclamp8(t.x), fclamp8(t.y), fclamp8(t.z), fclamp8(t.w)); } }
            }
            __syncthreads();
            if (tid < NE) __hip_atomic_store(CNT + vb * NE + tid, cntl[tid], __ATOMIC_RELAXED, __HIP_MEMORY_SCOPE_AGENT);
            __syncthreads();
        }
        asm volatile("s_waitcnt vmcnt(0)" ::: "memory");
        __syncthreads();
        if (tid == 0) __hip_atomic_fetch_add(ctl + CW_RDY, 1u, __ATOMIC_RELAXED, __HIP_MEMORY_SCOPE_AGENT);
        for (int it = (split ? MOE_EARLY + MOE_MID : 0) + gw; it < MOE_ITEMS; it += NGW) moe_conv_item(it, moe_w_gate, moe_w_up, moe_w_down, norm_ffn + D, WGUE, WDNE, lane);
        if (tid == 0) {
            unsigned sp = 0u;
            while (__hip_atomic_load(ctl + CW_RDY, __ATOMIC_RELAXED, __HIP_MEMORY_SCOPE_AGENT) < (unsigned)G) { __builtin_amdgcn_s_sleep(1);
                if ((++sp & 255u) == 0u) { if (__hip_atomic_load(ctl + CW_BAR + XB_TMO, __ATOMIC_RELAXED, __HIP_MEMORY_SCOPE_AGENT)) break; if (sp > XB_SPIN_CAP) { atomicAdd(ctl + CW_BAR + XB_TMO, 1u); break; } } } }
        __syncthreads();
        {
        LAS unsigned* sl = (LAS unsigned*)lds;
        for (int vb = vcu; vb < 256; vb += G) {
            { LAS unsigned* cl = sl + 256;
#pragma unroll
              for (int q = 0; q < 4; ++q) cl[tid + 512 * q] = __hip_atomic_load(CNT + tid + 512 * q, __ATOMIC_RELAXED, __HIP_MEMORY_SCOPE_AGENT);
              __syncthreads();
              if (tid < NE) { unsigned tot = 0u, pre = 0u;
                  for (int b2 = 0; b2 < 256; ++b2) { const unsigned c = cl[b2 * NE + tid]; pre += (b2 < vb) ? c : 0u; tot += c; }
                  sl[tid] = tot; sl[8 + tid] = pre; } }
            __syncthreads();
            if (tid == 0) { unsigned base = 0u;
                for (int e = 0; e < NE; ++e) { sl[16 + e] = base + sl[8 + e]; const unsigned pad = (sl[e] + 255u) & ~255u;
                    if (vb == 0) { for (unsigned t2 = base / 256u; t2 < (base + pad) / 256u; ++t2) __hip_atomic_store(TILEE + t2, (unsigned)e, __ATOMIC_RELAXED, __HIP_MEMORY_SCOPE_AGENT); }
                    base += pad; }
                if (vb == 0) __hip_atomic_store(NTILES, base / 256u, __ATOMIC_RELAXED, __HIP_MEMORY_SCOPE_AGENT); }
            __syncthreads();
            if (wave == 0) {
                const int m = vb * 64 + lane; unsigned run[NE];
#pragma unroll
                for (int e = 0; e < NE; ++e) run[e] = sl[16 + e];
#pragma unroll
                for (int k = 0; k < 2; ++k) { const int ek = TOKE[2 * m + k]; unsigned slot = 0u;
#pragma unroll
                    for (int e = 0; e < NE; ++e) { const unsigned long long mask = __ballot(ek == e); const unsigned below = (unsigned)__popcll(mask & ((1ull << lane) - 1ull));
                        if (ek == e) slot = run[e] + below; run[e] += (unsigned)__popcll(mask); }
                    TOKS[2 * m + k] = (int)slot; sl[32 + 2 * lane + k] = slot; }
            }
            __syncthreads();
            for (int i = 0; i < 8; ++i) { const int lr = wave * 8 + i, m = vb * 64 + lr; const u32x4 a0 = split ? ((const LAS u32x4*)(lds + P12_ROWS_OFF + lr * D))[lane] : ((const u32x4*)(HN3 + (size_t)m * D))[lane];
#pragma unroll
                for (int k = 0; k < 2; ++k) ((u32x4*)(XG + (size_t)sl[32 + 2 * lr + k] * D))[lane] = a0; }
            __syncthreads();
        }
        }
    }
    SEAM(13);
    if (IN(14) && MOEON) for (int rep_ = 0; rep_ < REPS(14); ++rep_) {
        const int ntl = (int)__builtin_amdgcn_readfirstlane(__hip_atomic_load(NTILES, __ATOMIC_RELAXED, __HIP_MEMORY_SCOPE_AGENT));
        LAS unsigned* tel = (LAS unsigned*)(lds + pg8::STAGE_BYTES + 2048);
        for (int i = tid; i < ntl; i += NWAVES * 64) tel[i] = __hip_atomic_load(TILEE + i, __ATOMIC_RELAXED, __HIP_MEMORY_SCOPE_AGENT);
        __syncthreads();
        pg8::Gemm g{XG, WGUE, D, D, D, (size_t)EGU_N * D}; pg8::StaticOrder S; S.init(ntl, EGU_N / 256, G, cb, tel, GDUP(14)); S.wgm = FP8_WGM;
        pg8::EpiSwiGLU8<false> E{HIDE, EF, 1.0f / WSC1, HSC, nullptr};
        pg8::gemm_phase<true>(lds, g, S, E);
    }
    SEAM(14);
    if (IN(15) && MOEON) for (int rep_ = 0; rep_ < REPS(15); ++rep_) {
        const int ntl = (int)__builtin_amdgcn_readfirstlane(__hip_atomic_load(NTILES, __ATOMIC_RELAXED, __HIP_MEMORY_SCOPE_AGENT));
        LAS unsigned* tel = (LAS unsigned*)(lds + pg8::STAGE_BYTES + 2048);
        for (int i = tid; i < ntl; i += NWAVES * 64) tel[i] = __hip_atomic_load(TILEE + i, __ATOMIC_RELAXED, __HIP_MEMORY_SCOPE_AGENT);
        __syncthreads();
        { pg8::Gemm g{HIDE, WDNE, EF, EF, EF, (size_t)D * EF}; pg8::StaticOrder S; S.init(ntl < P15_MAIN ? ntl : P15_MAIN, D / 256, G, cb, tel, GDUP(15));
          pg8::EpiF8 E{(unsigned char*)YB, D, YSC / (WSC2 * HSC)};
          pg8::gemm_phase<true>(lds, g, S, E); }
        { pg8::Gemm g{HIDE, WDNE, EF / P15_NS, EF, EF, (size_t)D * EF, EF / P15_NS}; pg8::SliceOrder S; S.init(P15_MAIN, ntl - P15_MAIN, D / 256, P15_NS, G, cb, tel);
          pg8::EpiBf16S E{YT, D, 1.0f / (WSC2 * HSC), P15_MAIN, (size_t)YT_ROWS * D};
          pg8::gemm_phase<true>(lds, g, S, E); }
    }
    SEAM(15);
    if (IN(16)) {
        const unsigned tmo = __hip_atomic_load(ctl + CW_BAR + XB_TMO, __ATOMIC_RELAXED, __HIP_MEMORY_SCOPE_AGENT);
        constexpr int TAIL0 = P15_MAIN * 256;
        for (int m0 = gw; m0 < M; m0 += 2 * NGW) {
            int sl[2][2]; float gg[2][2]; bool on[2];
#pragma unroll
            for (int q = 0; q < 2; ++q) { const int m = m0 + q * NGW; on[q] = m < M; const int mm = on[q] ? m : m0;
                sl[q][0] = 0; sl[q][1] = 0; gg[q][0] = 0.f; gg[q][1] = 0.f;
                if (MOEON) { sl[q][0] = TOKS[2 * mm]; sl[q][1] = TOKS[2 * mm + 1]; gg[q][0] = TOKG[2 * mm]; gg[q][1] = TOKG[2 * mm + 1]; } }
            u32x2 hb[2][4]; unsigned y8[2][2][4];
#pragma unroll
            for (int q = 0; q < 2; ++q) { const int mm = on[q] ? m0 + q * NGW : m0; const u32x2* hr = (const u32x2*)(XN + (size_t)mm * D) + lane;
#pragma unroll
                for (int j = 0; j < 4; ++j) hb[q][j] = __builtin_nontemporal_load(hr + 64 * j);
#pragma unroll
                for (int k = 0; k < 2; ++k) { const int sk = sl[q][k] < TAIL0 ? sl[q][k] : 0; const unsigned* y = (const unsigned*)((const unsigned char*)YB + (size_t)sk * D) + lane;
#pragma unroll
                    for (int j = 0; j < 4; ++j) y8[q][k][j] = MOEON ? __builtin_nontemporal_load(y + 64 * j) : 0u; } }
#pragma unroll
            for (int q = 0; q < 2; ++q) { if (!on[q]) continue;
                const int m = m0 + q * NGW; f32x4* xr = (f32x4*)(out + (size_t)m * D) + lane;
                f32x4 v[4]; float ss = 0.f;
                const bool t1 = sl[q][0] >= TAIL0, t2 = sl[q][1] >= TAIL0;
                const float k1 = t1 ? 0.f : gg[q][0] * (1.0f / YSC), k2 = t2 ? 0.f : gg[q][1] * (1.0f / YSC);
#pragma unroll
                for (int j = 0; j < 4; ++j) { v[j] = (f32x4){bflo(hb[q][j].x), bfhi(hb[q][j].x), bflo(hb[q][j].y), bfhi(hb[q][j].y)};
                    const f32x2 al = __builtin_amdgcn_cvt_pk_f32_fp8(y8[q][0][j], false), ah = __builtin_amdgcn_cvt_pk_f32_fp8(y8[q][0][j], true), bl = __builtin_amdgcn_cvt_pk_f32_fp8(y8[q][1][j], false), bh = __builtin_amdgcn_cvt_pk_f32_fp8(y8[q][1][j], true);
                    v[j].x += k1 * al.x + k2 * bl.x; v[j].y += k1 * al.y + k2 * bl.y; v[j].z += k1 * ah.x + k2 * bh.x; v[j].w += k1 * ah.y + k2 * bh.y; }
                if (MOEON && (t1 || t2)) {
                    const float h1 = t1 ? gg[q][0] : 0.f, h2 = t2 ? gg[q][1] : 0.f;
                    const u32x2* y1 = (const u32x2*)(YT + (size_t)(t1 ? sl[q][0] - TAIL0 : 0) * D) + lane; const u32x2* y2 = (const u32x2*)(YT + (size_t)(t2 ? sl[q][1] - TAIL0 : 0) * D) + lane;
                    for (int ks = 0; ks < P15_NS; ++ks) { const u32x2* z1 = y1 + (size_t)ks * YT_ROWS * (D / 4); const u32x2* z2 = y2 + (size_t)ks * YT_ROWS * (D / 4);
#pragma unroll
                        for (int j = 0; j < 4; ++j) { const u32x2 a = z1[64 * j], b = z2[64 * j];
                            v[j].x += h1 * bflo(a.x) + h2 * bflo(b.x); v[j].y += h1 * bfhi(a.x) + h2 * bfhi(b.x); v[j].z += h1 * bflo(a.y) + h2 * bflo(b.y); v[j].w += h1 * bfhi(a.y) + h2 * bfhi(b.y); } } }
#pragma unroll
                for (int j = 0; j < 4; ++j) ss += (v[j].x * v[j].x + v[j].y * v[j].y) + (v[j].z * v[j].z + v[j].w * v[j].w);
                float rstd = 1.0f / sqrtf(wave_sum(ss) * (1.f / D) + RMS_EPS);
                if (tmo) rstd = __builtin_nanf("");
#pragma unroll
                for (int j = 0; j < 4; ++j) { const f32x4 gn = *((const f32x4*)final_norm + lane + 64 * j); __builtin_nontemporal_store(v[j] * rstd * gn, xr + 64 * j); }
            }
        }
    }
#undef IN
#undef SEAM
}

extern "C" void kernel_launch(void* const* d_in, const int* in_sizes, int n_in, void* d_out, int out_size, void* d_ws, size_t ws_size, hipStream_t stream) {
    static int grid = 0;
    if (grid == 0) {
        if (n_in != 22 || in_sizes[0] != M * D || out_size != M * D || ws_size < WS_END) {
            fprintf(stderr, "kernel_launch: unexpected problem (n_in %d, in0 %d, out %d, ws %zu); nothing launched\n", n_in, n_in > 0 ? in_sizes[0] : -1, out_size, ws_size); grid = -1; return; }
        int dev = 0, cus = 0, per_cu = 0;
        if (hipGetDevice(&dev) != hipSuccess || hipDeviceGetAttribute(&cus, hipDeviceAttributeMultiprocessorCount, dev) != hipSuccess) { grid = -1; return; }
        if (hipFuncSetAttribute((const void*)trunk_fwd, hipFuncAttributeMaxDynamicSharedMemorySize, LDS_BYTES) != hipSuccess) { fprintf(stderr, "kernel_launch: hipFuncSetAttribute failed\n"); grid = -1; return; }
        if (hipOccupancyMaxActiveBlocksPerMultiprocessor(&per_cu, (const void*)trunk_fwd, NWAVES * 64, LDS_BYTES) != hipSuccess || per_cu < 1)
            fprintf(stderr, "kernel_launch: note: occupancy query reports %d workgroups per CU\n", per_cu);
        (void)hipGetLastError();
        grid = cus;
    }
    if (grid < 0) return;
    (void)hipMemsetAsync((char*)d_ws + WS_CTL, 0, CTL_ZERO_BYTES, stream);
    Args a{};
    for (int i = 0; i < 22; ++i) a.in[i] = (const float*)d_in[i];
    a.pos = (const int*)d_in[1]; a.out = (float*)d_out; a.ws = (unsigned char*)d_ws;
#if MK_PER_PHASE
    for (int p = 0; p < NPHASE; ++p) { a.ph_lo = p; a.ph_hi = p + 1; hipLaunchKernelGGL(trunk_fwd, dim3(grid), dim3(NWAVES * 64), LDS_BYTES, stream, a); }
#else
    a.ph_lo = 0; a.ph_hi = NPHASE;
    hipLaunchKernelGGL(trunk_fwd, dim3(grid), dim3(NWAVES * 64), LDS_BYTES, stream, a);
#endif
    const hipError_t le = hipPeekAtLastError();
    if (le != hipSuccess) fprintf(stderr, "kernel_launch: launch failed: %s\n", hipGetErrorName(le));
}
```

```cpp
#include <hip/hip_runtime.h>
#include <cstdio>
#include <cstdint>

#define LAS __attribute__((address_space(3)))
#define GAS __attribute__((address_space(1)))
typedef unsigned short bf16_t;
typedef short bf16x8 __attribute__((ext_vector_type(8)));
typedef short s16x4 __attribute__((ext_vector_type(4)));
typedef float f32x2 __attribute__((ext_vector_type(2)));
typedef float f32x4 __attribute__((ext_vector_type(4)));
typedef float f32x16 __attribute__((ext_vector_type(16)));
typedef unsigned u32x2 __attribute__((ext_vector_type(2)));
typedef unsigned u32x4 __attribute__((ext_vector_type(4)));
typedef __bf16 bf16x2_t __attribute__((ext_vector_type(2)));

#ifndef MK_PER_PHASE
#define MK_PER_PHASE 0
#endif
#ifndef FFN8
#define FFN8 0
#endif
#ifndef FFN8D
#define FFN8D 1
#endif
#ifndef FP8_WGM
#define FP8_WGM 4
#endif
#ifndef DBG_STOP
#define DBG_STOP 0
#endif

__device__ __forceinline__ unsigned pk2(float lo, float hi) { f32x2 v = {lo, hi}; bf16x2_t b = __builtin_convertvector(v, bf16x2_t); return __builtin_bit_cast(unsigned, b); }
__device__ __forceinline__ unsigned pk4f8(float a, float b, float c, float d) { unsigned w = 0u; w = __builtin_amdgcn_cvt_pk_fp8_f32(a, b, w, false); w = __builtin_amdgcn_cvt_pk_fp8_f32(c, d, w, true); return w; }
__device__ __forceinline__ float fclamp8(float v) { return __builtin_fminf(__builtin_fmaxf(v, -448.f), 448.f); }
__device__ __forceinline__ float bflo(unsigned u) { return __uint_as_float(u << 16); }
__device__ __forceinline__ float bfhi(unsigned u) { return __uint_as_float(u & 0xffff0000u); }
__device__ __forceinline__ float wave_sum(float v) {
#pragma unroll
    for (int o = 1; o < 64; o <<= 1) v += __shfl_xor(v, o);
    return v;
}

constexpr int BATCH = 8, SEQ = 2048, M = BATCH * SEQ, D = 1024;
constexpr int QL = 384, KVL = 256, DOWN_N = 768  , UQ_N = 1536, UKV_N = 2048;
constexpr int FF = 2816, GU_N = 2 * FF, KVQ_N = 9216;
constexpr int NE = 8, EF = 3584, EGU_N = 2 * EF, RMAX = 34816;
constexpr float RMS_EPS = 1e-6f;
constexpr float LOG2E = 1.4426950408889634f;
constexpr float QSCALE_MLA = 0.10206207261596575f * LOG2E;
constexpr float QSCALE_DSW = 0.125f * LOG2E;

namespace pg8 {
constexpr int BM = 256, BK = 64, HALF = 128, HTB = HALF * BK * 2, STAGE_BYTES = 8 * HTB, NXCD = 8, WGM = 4;
__host__ __device__ __forceinline__ int lds_byte(int r, int c) { const int st = (r >> 4) * 2 + (c >> 5), rr = r & 15, cc = c & 31, ob = rr * 64 + cc * 2; return st * 1024 + (ob ^ (((ob >> 9) & 1) << 5)); }
__host__ __device__ __forceinline__ void stage_rc(int b, int& R, int& C) { const int st = b / 1024, sb = b % 1024, swz = sb ^ (((sb >> 9) & 1) << 5); R = (st >> 1) * 16 + swz / 64; C = (st & 1) * 32 + (swz % 64) / 2; }
__host__ __device__ __forceinline__ int perm32(int rho) { const int n = rho >> 4, i = rho & 15; return 8 * (i >> 2) + 4 * n + (i & 3); }

struct Unit { int pm, pn, e, ks; };
struct Gemm { const void* A; const void* Bt; int kb, lda, ldb; size_t bgs; int kso = 0; };
typedef int v4i_t __attribute__((ext_vector_type(4)));
typedef int v8i_t __attribute__((ext_vector_type(8)));

struct StaticOrder {
    int nM, nN, nwg, G, c, dup, wgm; const LAS unsigned* tile_e;
    __device__ void init(int nM_, int nN_, int G_, int c_, const LAS unsigned* te, int dup_ = 1) { nM = nM_; nN = nN_; nwg = nM * nN; G = G_; c = c_; tile_e = te; dup = dup_; wgm = WGM; }
    __device__ bool next(int i, Unit& u) const {
#if defined(DUP_CYCLIC) && DUP_CYCLIC
        const int nround = (nwg - c + G - 1) / G;
        if (nround <= 0 || i >= nround * dup) return false;
        const long L = (long)(i % nround) * G + c;
#else
        const long L = (long)(i / dup) * G + c; if (L >= nwg) return false;
#endif
        int wgid = (int)L; { const int q = nwg / NXCD, r = nwg % NXCD, xcd = wgid % NXCD, off = wgid / NXCD; wgid = (xcd < r ? xcd * (q + 1) : r * (q + 1) + (xcd - r) * q) + off; }
        const int nig = wgm * nN, gid = wgid / nig, fm = gid * wgm, gsz = (nM - fm) < wgm ? (nM - fm) : wgm;
        u.pm = fm + ((wgid % nig) % gsz); u.pn = (wgid % nig) / gsz;
        u.e = tile_e ? (int)__builtin_amdgcn_readfirstlane(tile_e[u.pm]) : 0; u.ks = 0;
        return true;
    }
};

struct SliceOrder {
    int pm0, nN, ns, nwg, G, c; const LAS unsigned* tile_e;
    __device__ void init(int pm0_, int nM_, int nN_, int ns_, int G_, int c_, const LAS unsigned* te) { pm0 = pm0_; nN = nN_; ns = ns_; nwg = (nM_ > 0 ? nM_ : 0) * nN_ * ns_; G = G_; c = c_; tile_e = te; }
    __device__ __forceinline__ bool next(int i, Unit& u) const {
        const long L = (long)i * G + c; if (L >= nwg) return false;
        const int t = (int)L / ns; u.ks = (int)L - t * ns; u.pm = pm0 + t / nN; u.pn = t % nN;
        u.e = tile_e ? (int)__builtin_amdgcn_readfirstlane(tile_e[u.pm]) : 0;
        return true;
    }
};

__device__ __forceinline__ float row_rstd(const float* ssq, int row) {
    const f32x4* p = (const f32x4*)(ssq + (size_t)row * 16); const f32x4 a = p[0], b = p[1], c = p[2], d = p[3];
    const float s = (((a[0] + a[1]) + (a[2] + a[3])) + ((b[0] + b[1]) + (b[2] + b[3]))) + (((c[0] + c[1]) + (c[2] + c[3])) + ((d[0] + d[1]) + (d[2] + d[3])));
    return 1.0f / sqrtf(s * (1.f / D) + RMS_EPS);
}
template <int STRIDE, int LO, int HALFN, int DIM>
__device__ __forceinline__ void rstd_prep_g(const float* ssq, int pm, int tid, LAS unsigned char* xl) {
    const float* p = ssq + ((size_t)pm * BM + (tid >> 1)) * STRIDE + LO + HALFN * (tid & 1);
    float s2 = 0.f;
    if constexpr (HALFN % 4 == 0) {
#pragma unroll
        for (int q = 0; q < HALFN / 4; ++q) { const f32x4 a = *(const f32x4*)(p + 4 * q); s2 += (a[0] + a[1]) + (a[2] + a[3]); }
    } else {
#pragma unroll
        for (int q = 0; q < HALFN / 2; ++q) { const f32x2 a = *(const f32x2*)(p + 2 * q); s2 += a[0] + a[1]; }
    }
    s2 += __shfl_xor(s2, 1);
    if ((tid & 1) == 0) ((LAS float*)xl)[tid >> 1] = 1.0f / sqrtf(s2 * (1.f / DIM) + RMS_EPS);
    asm volatile("s_waitcnt lgkmcnt(0)" ::: "memory"); __builtin_amdgcn_s_barrier(); asm volatile("" ::: "memory");
}
__device__ __forceinline__ void rstd_prep(const float* ssq, int pm, int tid, LAS unsigned char* xl) { rstd_prep_g<16, 0, 8, D>(ssq, pm, tid, xl); }
struct EpiBf16 {
    static constexpr bool PERM = true, HAS_PREP = false;
    bf16_t* O; int ldc; float sc;
    __device__ __forceinline__ void operator()(const f32x4 (&acc)[2][2][4][2], const Unit& u, int wr, int wc, int fr, int fq, const LAS unsigned char* xl) const {
        const int row0 = u.pm * BM + wr * 64 + fr, col0 = u.pn * BM + wc * 32 + 8 * fq;
#pragma unroll
        for (int ai = 0; ai < 2; ++ai)
#pragma unroll
            for (int m = 0; m < 4; ++m) { bf16_t* rowp = O + (size_t)(row0 + ai * HALF + m * 16) * ldc + col0;
#pragma unroll
                for (int bj = 0; bj < 2; ++bj) { const f32x4 v0 = acc[ai][bj][m][0] * sc, v1 = acc[ai][bj][m][1] * sc;
                    u32x4 w; w.x = pk2(v0[0], v0[1]); w.y = pk2(v0[2], v0[3]); w.z = pk2(v1[0], v1[1]); w.w = pk2(v1[2], v1[3]);
                    *(u32x4*)(rowp + bj * HALF) = w; } }
    }
};
struct EpiBf16S {
    static constexpr bool PERM = true, HAS_PREP = false;
    bf16_t* O; int ldc; float sc; int pm0; size_t sst;
    __device__ __forceinline__ void operator()(const f32x4 (&acc)[2][2][4][2], const Unit& u, int wr, int wc, int fr, int fq, const LAS unsigned char* xl) const {
        const int row0 = (u.pm - pm0) * BM + wr * 64 + fr, col0 = u.pn * BM + wc * 32 + 8 * fq;
        bf16_t* Os = O + (size_t)u.ks * sst;
#pragma unroll
        for (int ai = 0; ai < 2; ++ai)
#pragma unroll
            for (int m = 0; m < 4; ++m) { bf16_t* rowp = Os + (size_t)(row0 + ai * HALF + m * 16) * ldc + col0;
#pragma unroll
                for (int bj = 0; bj < 2; ++bj) { const f32x4 v0 = acc[ai][bj][m][0] * sc, v1 = acc[ai][bj][m][1] * sc;
                    u32x4 w; w.x = pk2(v0[0], v0[1]); w.y = pk2(v0[2], v0[3]); w.z = pk2(v1[0], v1[1]); w.w = pk2(v1[2], v1[3]);
                    *(u32x4*)(rowp + bj * HALF) = w; } }
    }
};
struct EpiF8 {
    static constexpr bool PERM = true, HAS_PREP = false;
    unsigned char* O; int ldc; float sc;
    __device__ __forceinline__ void operator()(const f32x4 (&acc)[2][2][4][2], const Unit& u, int wr, int wc, int fr, int fq, const LAS unsigned char* xl) const {
        const int row0 = u.pm * BM + wr * 64 + fr, col0 = u.pn * BM + wc * 32 + 8 * fq;
        u32x2 wprev[2] = {};
#pragma unroll
        for (int ai = 0; ai < 2; ++ai)
#pragma unroll
            for (int m = 0; m < 4; ++m) {
#pragma unroll
                for (int bj = 0; bj < 2; ++bj) { const f32x4 v0 = acc[ai][bj][m][0] * sc, v1 = acc[ai][bj][m][1] * sc;
                    u32x2 w; w.x = pk4f8(fclamp8(v0[0]), fclamp8(v0[1]), fclamp8(v0[2]), fclamp8(v0[3])); w.y = pk4f8(fclamp8(v1[0]), fclamp8(v1[1]), fclamp8(v1[2]), fclamp8(v1[3]));
                    if ((m & 1) == 0) wprev[bj] = w;
                    else { const auto r0 = __builtin_amdgcn_permlane16_swap(wprev[bj].x, w.x, false, false), r1 = __builtin_amdgcn_permlane16_swap(wprev[bj].y, w.y, false, false);
                        const u32x4 q = {r0[0], r1[0], r0[1], r1[1]};
                        *(u32x4*)(O + (size_t)(row0 + ai * HALF + (m - 1 + (fq & 1)) * 16) * ldc + (col0 - 8 * (fq & 1)) + bj * HALF) = q; } } }
    }
};
struct EpiDown {
    static constexpr bool PERM = true, HAS_PREP = false;
    bf16_t* O; int ldc; float* ssq; bf16_t* KR; const float* rope;
    __device__ __forceinline__ void operator()(const f32x4 (&acc)[2][2][4][2], const Unit& u, int wr, int wc, int fr, int fq, const LAS unsigned char* xl) const {
        const int row0 = u.pm * BM + wr * 64 + fr, col0 = u.pn * BM + wc * 32 + 8 * fq;
        const bool kr = (u.pn == 2) && (wc == 0);
#pragma unroll
        for (int ai = 0; ai < 2; ++ai)
#pragma unroll
            for (int m = 0; m < 4; ++m) { const int row = row0 + ai * HALF + m * 16; bf16_t* rowp = O + (size_t)row * ldc + col0;
#pragma unroll
                for (int bj = 0; bj < 2; ++bj) { const f32x4 v0 = acc[ai][bj][m][0], v1 = acc[ai][bj][m][1];
                    u32x4 w; w.x = pk2(v0[0], v0[1]); w.y = pk2(v0[2], v0[3]); w.z = pk2(v1[0], v1[1]); w.w = pk2(v1[2], v1[3]);
                    *(u32x4*)(rowp + bj * HALF) = w;
                    float sq = ((v0[0] * v0[0] + v0[1] * v0[1]) + (v0[2] * v0[2] + v0[3] * v0[3])) + ((v1[0] * v1[0] + v1[1] * v1[1]) + (v1[2] * v1[2] + v1[3] * v1[3]));
                    sq += __shfl_xor(sq, 16); sq += __shfl_xor(sq, 32);
                    if (fq == 0) ssq[(size_t)row * 24 + u.pn * 8 + bj * 4 + wc] = sq;
                    if (bj == 1 && kr) { const f32x4 cs0 = *(const f32x4*)(rope + (size_t)row * 32 + 8 * fq), cs1 = *(const f32x4*)(rope + (size_t)row * 32 + 8 * fq + 4);
                        u32x4 k; k.x = pk2(v0[0] * cs0[0] - v0[1] * cs0[1], v0[1] * cs0[0] + v0[0] * cs0[1]); k.y = pk2(v0[2] * cs0[2] - v0[3] * cs0[3], v0[3] * cs0[2] + v0[2] * cs0[3]);
                        k.z = pk2(v1[0] * cs1[0] - v1[1] * cs1[1], v1[1] * cs1[0] + v1[0] * cs1[1]); k.w = pk2(v1[2] * cs1[2] - v1[3] * cs1[3], v1[3] * cs1[2] + v1[2] * cs1[3]);
                        *(u32x4*)(KR + (size_t)row * 32 + 8 * fq) = k; } } }
    }
};
struct EpiBf16KV {
    static constexpr bool PERM = true, HAS_PREP = true;
    bf16_t* O; int ldc; const float* ssq;
    __device__ __forceinline__ void prep(LAS unsigned char* xl, const Unit& u, int tid) const { rstd_prep_g<24, 12, 4, KVL>(ssq, u.pm, tid, xl); }
    __device__ __forceinline__ void operator()(const f32x4 (&acc)[2][2][4][2], const Unit& u, int wr, int wc, int fr, int fq, const LAS unsigned char* xl) const {
        const int row0 = u.pm * BM + wr * 64 + fr, col0 = u.pn * BM + wc * 32 + 8 * fq;
#pragma unroll
        for (int ai = 0; ai < 2; ++ai)
#pragma unroll
            for (int m = 0; m < 4; ++m) { bf16_t* rowp = O + (size_t)(row0 + ai * HALF + m * 16) * ldc + col0; const float sc = ((const LAS float*)xl)[wr * 64 + ai * HALF + m * 16 + fr];
#pragma unroll
                for (int bj = 0; bj < 2; ++bj) { const f32x4 v0 = acc[ai][bj][m][0] * sc, v1 = acc[ai][bj][m][1] * sc;
                    u32x4 w; w.x = pk2(v0[0], v0[1]); w.y = pk2(v0[2], v0[3]); w.z = pk2(v1[0], v1[1]); w.w = pk2(v1[2], v1[3]);
                    *(u32x4*)(rowp + bj * HALF) = w; } }
    }
};
struct EpiQRope {
    static constexpr bool PERM = true, HAS_PREP = true;
    bf16_t* O; int ldc; const float* rope; const float* ssq;
    __device__ __forceinline__ void prep(LAS unsigned char* xl, const Unit& u, int tid) const { rstd_prep_g<24, 0, 6, QL>(ssq, u.pm, tid, xl); }
    __device__ __forceinline__ void operator()(const f32x4 (&acc)[2][2][4][2], const Unit& u, int wr, int wc, int fr, int fq, const LAS unsigned char* xl) const {
        const int row0 = u.pm * BM + wr * 64 + fr, col0 = u.pn * BM + wc * 32 + 8 * fq;
        const int ch0 = (u.pn * 8 + wc) % 3;
        const bool rp0 = (ch0 == 2), rp1 = (ch0 == 1), anyr = rp0 || rp1;
#pragma unroll
        for (int ai = 0; ai < 2; ++ai) {
            f32x4 cs0[4], cs1[4];
            if (anyr) {
#pragma unroll
                for (int m = 0; m < 4; ++m) { const float* rp = rope + (size_t)(row0 + ai * HALF + m * 16) * 32 + 8 * fq; cs0[m] = *(const f32x4*)rp; cs1[m] = *(const f32x4*)(rp + 4); }
            }
#pragma unroll
            for (int m = 0; m < 4; ++m) { const int row = row0 + ai * HALF + m * 16; bf16_t* rowp = O + (size_t)row * ldc + col0;
                const float qsc = ((const LAS float*)xl)[wr * 64 + ai * HALF + m * 16 + fr] * QSCALE_MLA;
#pragma unroll
                for (int bj = 0; bj < 2; ++bj) { f32x4 v0 = acc[ai][bj][m][0], v1 = acc[ai][bj][m][1];
                    if (bj == 0 ? rp0 : rp1) {
                        f32x4 r0, r1;
                        r0[0] = v0[0] * cs0[m][0] - v0[1] * cs0[m][1]; r0[1] = v0[1] * cs0[m][0] + v0[0] * cs0[m][1];
                        r0[2] = v0[2] * cs0[m][2] - v0[3] * cs0[m][3]; r0[3] = v0[3] * cs0[m][2] + v0[2] * cs0[m][3];
                        r1[0] = v1[0] * cs1[m][0] - v1[1] * cs1[m][1]; r1[1] = v1[1] * cs1[m][0] + v1[0] * cs1[m][1];
                        r1[2] = v1[2] * cs1[m][2] - v1[3] * cs1[m][3]; r1[3] = v1[3] * cs1[m][2] + v1[2] * cs1[m][3];
                        v0 = r0; v1 = r1; }
                    v0 = v0 * qsc; v1 = v1 * qsc;
                    u32x4 w; w.x = pk2(v0[0], v0[1]); w.y = pk2(v0[2], v0[3]); w.z = pk2(v1[0], v1[1]); w.w = pk2(v1[2], v1[3]);
                    *(u32x4*)(rowp + bj * HALF) = w; } }
            asm volatile("" ::: "memory");
        }
    }
};
struct EpiKVQ {
    static constexpr bool PERM = true, HAS_PREP = true;
    unsigned char* O; int ldc; const float* rope; float isc; const float* ssq;
    static constexpr int ROPE_LDS = 4096;
    __device__ __forceinline__ void prep(LAS unsigned char* xl, const Unit& u, int tid) const {
        { const float* rp = rope + ((size_t)u.pm * BM + (tid >> 1)) * 16 + 8 * (tid & 1); const f32x4 a = *(const f32x4*)rp, b = *(const f32x4*)(rp + 4);
          u32x4 w; w.x = pk2(a[0], a[1]); w.y = pk2(a[2], a[3]); w.z = pk2(b[0], b[1]); w.w = pk2(b[2], b[3]);
          *(LAS u32x4*)(xl + ROPE_LDS + (tid >> 1) * 32 + (tid & 1) * 16) = w; }
        rstd_prep(ssq, u.pm, tid, xl); }
    __device__ __forceinline__ void operator()(const f32x4 (&acc)[2][2][4][2], const Unit& u, int wr, int wc, int fr, int fq, const LAS unsigned char* xl) const {
        const int row0 = u.pm * BM + wr * 64 + fr, col0 = u.pn * BM + wc * 32 + 8 * fq;
        const bool isv = (u.pn >= 12 && u.pn < 24);
        const bool ropew = (!isv) && ((wc & 1) == 0);
        const float sc = isc;
        const LAS float* rt = (const LAS float*)xl;
        const int part = u.pn / 12, gbr = (u.pn % 12) >> 2, ldil = 2 * gbr;
        const int blk0 = ((part * 3 + gbr) * BATCH) * 16 + 4 * (u.pn & 3) + (wc >> 1), dcol = 32 * (wc & 1) + 8 * fq;
        u32x2 wprev[2] = {}; unsigned char* rowprev = O;
#pragma unroll
        for (int ai = 0; ai < 2; ++ai) {
#pragma unroll
            for (int m = 0; m < 4; ++m) { const int row = row0 + ai * HALF + m * 16;
                f32x4 c0 = {}, c1 = {};
                if (ropew) { const u32x4 cw = *(const LAS u32x4*)(xl + ROPE_LDS + (wr * 64 + ai * HALF + m * 16 + fr) * 32 + (fq & 1) * 16);
                    c0 = (f32x4){bflo(cw.x), bfhi(cw.x), bflo(cw.y), bfhi(cw.y)}; c1 = (f32x4){bflo(cw.z), bfhi(cw.z), bflo(cw.w), bfhi(cw.w)}; }
                const int tt = row & (SEQ - 1), rho = ((tt & ((1 << ldil) - 1)) << (11 - ldil)) + (tt >> ldil);
                unsigned char* rowp = O + ((size_t)(blk0 + (row >> 11) * 16) * SEQ + rho) * 64 + dcol;
                const float rsc = rt[wr * 64 + ai * HALF + m * 16 + fr] * sc;
#pragma unroll
                for (int bj = 0; bj < 2; ++bj) { f32x4 v0 = acc[ai][bj][m][0], v1 = acc[ai][bj][m][1];
                    if (ropew) {
                        f32x4 r0, r1;
                        r0[0] = v0[0] * c0[0] - v0[1] * c0[1]; r0[1] = v0[1] * c0[0] + v0[0] * c0[1];
                        r0[2] = v0[2] * c0[2] - v0[3] * c0[3]; r0[3] = v0[3] * c0[2] + v0[2] * c0[3];
                        r1[0] = v1[0] * c1[0] - v1[1] * c1[1]; r1[1] = v1[1] * c1[0] + v1[0] * c1[1];
                        r1[2] = v1[2] * c1[2] - v1[3] * c1[3]; r1[3] = v1[3] * c1[2] + v1[2] * c1[3];
                        if (fq < 2) { v0 = r0; v1 = r1; } }
                    v0 = v0 * rsc; v1 = v1 * rsc;
                    u32x2 w; w.x = pk4f8(fclamp8(v0[0]), fclamp8(v0[1]), fclamp8(v0[2]), fclamp8(v0[3])); w.y = pk4f8(fclamp8(v1[0]), fclamp8(v1[1]), fclamp8(v1[2]), fclamp8(v1[3]));
                    if ((m & 1) == 0) wprev[bj] = w;
                    else { const auto r0 = __builtin_amdgcn_permlane16_swap(wprev[bj].x, w.x, false, false), r1 = __builtin_amdgcn_permlane16_swap(wprev[bj].y, w.y, false, false);
                        const u32x4 q = {r0[0], r1[0], r0[1], r1[1]};
                        unsigned char* rp = (fq & 1) ? rowp : rowprev;
                        *(u32x4*)(rp - 8 * (fq & 1) + (size_t)bj * 2 * SEQ * 64) = q; } }
                if ((m & 1) == 0) rowprev = rowp; }
            asm volatile("" ::: "memory");
        }
    }
};
template <int MODE, bool BASEF32, bool BSC = false, long BDELTA = 0> struct EpiResidB {
    static constexpr bool PERM = true, HAS_PREP = false;
    const void* base; bf16_t* hb; int ldc; unsigned char* cp8; float* ssq; float asc;
    __device__ __forceinline__ void operator()(const f32x4 (&acc)[2][2][4][2], const Unit& u, int wr, int wc, int fr, int fq, const LAS unsigned char* xl) const {
        const int row0 = u.pm * BM + wr * 64 + fr, col0 = u.pn * BM + wc * 32 + 8 * fq;
        f32x4 nb0 = {}, nb1 = {}; u32x4 nbb = {}; float nsc = 1.0f;
        const float* bsc = (const float*)((const char*)hb + BDELTA);
        if (BSC) nsc = bsc[row0];
        { const size_t off = (size_t)row0 * ldc + col0;
          if (BASEF32) { nb0 = __builtin_nontemporal_load((const f32x4*)((const float*)base + off)); nb1 = __builtin_nontemporal_load((const f32x4*)((const float*)base + off + 4)); } else nbb = *(const u32x4*)((const bf16_t*)base + off); }
        float sq = 0.f;
#pragma unroll
        for (int st = 0; st < 16; ++st) { const int ai = st >> 3, m = (st >> 1) & 3, bj = st & 1;
            const int row = row0 + ai * HALF + m * 16; const size_t off = (size_t)row * ldc + col0 + bj * HALF;
            f32x4 b0, b1;
            if (BASEF32) { b0 = nb0; b1 = nb1; } else { b0 = (f32x4){bflo(nbb.x), bfhi(nbb.x), bflo(nbb.y), bfhi(nbb.y)}; b1 = (f32x4){bflo(nbb.z), bfhi(nbb.z), bflo(nbb.w), bfhi(nbb.w)}; }
            if (BSC) { b0 = b0 * nsc; b1 = b1 * nsc; }
            if (st + 1 < 16) { const int s2 = st + 1, ai2 = s2 >> 3, m2 = (s2 >> 1) & 3, bj2 = s2 & 1; const size_t off2 = (size_t)(row0 + ai2 * HALF + m2 * 16) * ldc + col0 + bj2 * HALF;
                if (BASEF32) { nb0 = __builtin_nontemporal_load((const f32x4*)((const float*)base + off2)); nb1 = __builtin_nontemporal_load((const f32x4*)((const float*)base + off2 + 4)); } else nbb = *(const u32x4*)((const bf16_t*)base + off2);
                if (BSC && bj2 == 0) nsc = bsc[row0 + ai2 * HALF + m2 * 16];
                asm volatile("" ::: "memory"); }
            if (bj == 0) sq = 0.f;
            const f32x4 v0 = b0 + acc[ai][bj][m][0] * asc, v1 = b1 + acc[ai][bj][m][1] * asc;
            { u32x4 w; w.x = pk2(v0[0], v0[1]); w.y = pk2(v0[2], v0[3]); w.z = pk2(v1[0], v1[1]); w.w = pk2(v1[2], v1[3]); *(u32x4*)(hb + off) = w; }
            if (MODE != 0) sq += ((v0[0] * v0[0] + v0[1] * v0[1]) + (v0[2] * v0[2] + v0[3] * v0[3])) + ((v1[0] * v1[0] + v1[1] * v1[1]) + (v1[2] * v1[2] + v1[3] * v1[3]));
            if (MODE == 2) { u32x2 w; w.x = pk4f8(fclamp8(v0[0]), fclamp8(v0[1]), fclamp8(v0[2]), fclamp8(v0[3])); w.y = pk4f8(fclamp8(v1[0]), fclamp8(v1[1]), fclamp8(v1[2]), fclamp8(v1[3])); *(u32x2*)(cp8 + off) = w; }
            if (MODE != 0 && bj == 1) { sq += __shfl_xor(sq, 16); sq += __shfl_xor(sq, 32); if (fq == 0) ssq[(size_t)row * 16 + u.pn * 4 + wc] = sq; } }
    }
};
template <bool F8OUT> struct EpiSwiGLU {
    static constexpr bool PERM = true, HAS_PREP = true;
    bf16_t* O; int ldh; const float* ssq; float osc;
    __device__ __forceinline__ void prep(LAS unsigned char* xl, const Unit& u, int tid) const { rstd_prep(ssq, u.pm, tid, xl); }
    __device__ __forceinline__ void operator()(const f32x4 (&acc)[2][2][4][2], const Unit& u, int wr, int wc, int fr, int fq, const LAS unsigned char* xl) const {
        const int row0 = u.pm * BM + wr * 64 + fr, col0 = u.pn * HALF + wc * 32 + 8 * fq;
#pragma unroll
        for (int ai = 0; ai < 2; ++ai)
#pragma unroll
            for (int m = 0; m < 4; ++m) { const int row = row0 + ai * HALF + m * 16; bf16_t* rowp = O + (size_t)row * ldh + col0;
                const float rstd = ((const LAS float*)xl)[wr * 64 + ai * HALF + m * 16 + fr];
                float hv[8]; const float ge = -rstd * LOG2E, us = rstd * rstd;
#pragma unroll
                for (int n = 0; n < 2; ++n) { const f32x4 ag = acc[ai][0][m][n], au = acc[ai][1][m][n], tt = ag * ge; f32x4 den, rc;
#pragma unroll
                    for (int i = 0; i < 4; ++i) den[i] = __builtin_amdgcn_exp2f(tt[i]);
                    den = den + 1.0f;
#pragma unroll
                    for (int i = 0; i < 4; ++i) rc[i] = __builtin_amdgcn_rcpf(den[i]);
                    const f32x4 pv = (ag * (au * us)) * rc;
#pragma unroll
                    for (int i = 0; i < 4; ++i) hv[n * 4 + i] = pv[i]; }
                if constexpr (F8OUT) { u32x2 w;
                    w.x = pk4f8(__builtin_amdgcn_fmed3f(hv[0] * osc, -448.f, 448.f), __builtin_amdgcn_fmed3f(hv[1] * osc, -448.f, 448.f), __builtin_amdgcn_fmed3f(hv[2] * osc, -448.f, 448.f), __builtin_amdgcn_fmed3f(hv[3] * osc, -448.f, 448.f));
                    w.y = pk4f8(__builtin_amdgcn_fmed3f(hv[4] * osc, -448.f, 448.f), __builtin_amdgcn_fmed3f(hv[5] * osc, -448.f, 448.f), __builtin_amdgcn_fmed3f(hv[6] * osc, -448.f, 448.f), __builtin_amdgcn_fmed3f(hv[7] * osc, -448.f, 448.f));
                    *(u32x2*)((unsigned char*)O + (size_t)row * ldh + col0) = w; }
                else { u32x4 w; w.x = pk2(hv[0], hv[1]); w.y = pk2(hv[2], hv[3]); w.z = pk2(hv[4], hv[5]); w.w = pk2(hv[6], hv[7]);
                    *(u32x4*)rowp = w; } }
    }
};

template <bool NORM> struct EpiSwiGLU8 {
    static constexpr bool PERM = true, HAS_PREP = NORM;
    unsigned char* O; int ldh; float isc, osc; const float* ssq;
    __device__ __forceinline__ void prep(LAS unsigned char* xl, const Unit& u, int tid) const { rstd_prep(ssq, u.pm, tid, xl); }
    __device__ __forceinline__ void operator()(const f32x4 (&acc)[2][2][4][2], const Unit& u, int wr, int wc, int fr, int fq, const LAS unsigned char* xl) const {
        const int row0 = u.pm * BM + wr * 64 + fr, col0 = u.pn * HALF + wc * 32 + 8 * fq;
        u32x2 wprev = {0u, 0u};
#pragma unroll
        for (int ai = 0; ai < 2; ++ai)
#pragma unroll
            for (int m = 0; m < 4; ++m) {
                const float rs = NORM ? ((const LAS float*)xl)[wr * 64 + ai * HALF + m * 16 + fr] * isc : isc;
                const float ge = -rs * LOG2E, us = rs * rs * osc;
                f32x4 hv[2];
#pragma unroll
                for (int n = 0; n < 2; ++n) { const f32x4 ag = acc[ai][0][m][n], au = acc[ai][1][m][n], tt = ag * ge; f32x4 den, rc;
#pragma unroll
                    for (int i = 0; i < 4; ++i) den[i] = __builtin_amdgcn_exp2f(tt[i]);
                    den = den + 1.0f;
#pragma unroll
                    for (int i = 0; i < 4; ++i) rc[i] = __builtin_amdgcn_rcpf(den[i]);
                    const f32x4 pv = (ag * (au * us)) * rc;
#pragma unroll
                    for (int i = 0; i < 4; ++i) hv[n][i] = __builtin_amdgcn_fmed3f(pv[i], -448.f, 448.f); }
                u32x2 w; w.x = pk4f8(hv[0][0], hv[0][1], hv[0][2], hv[0][3]); w.y = pk4f8(hv[1][0], hv[1][1], hv[1][2], hv[1][3]);
                if ((m & 1) == 0) wprev = w;
                else { const auto r0 = __builtin_amdgcn_permlane16_swap(wprev.x, w.x, false, false), r1 = __builtin_amdgcn_permlane16_swap(wprev.y, w.y, false, false);
                    const u32x4 q = {r0[0], r1[0], r0[1], r1[1]};
                    *(u32x4*)(O + (size_t)(row0 + ai * HALF + (m - 1 + (fq & 1)) * 16) * ldh + (col0 - 8 * (fq & 1))) = q; } }
    }
};

template <bool FP8, class Epi, class Sched>
__device__ __forceinline__ void gemm_phase(LAS unsigned char* lds, const Gemm g, const Sched& S, const Epi& E) {
    const int tid = threadIdx.x, wid = __builtin_amdgcn_readfirstlane(tid >> 6), lane = tid & 63, wr = wid >> 2, wc = wid & 3, fr = lane & 15, fq = lane >> 4;
    int nt = g.kb / (BK * 2); asm volatile("" : "+s"(nt));
    unsigned voffA[2], voffB[2];
#pragma unroll
    for (int i = 0; i < 2; ++i) { int R, C; stage_rc(tid * 16 + i * 8192, R, C); const int Rb = Epi::PERM ? ((R & ~31) + perm32(R & 31)) : R;
        voffA[i] = (unsigned)(R * g.lda + C * 2); voffB[i] = (unsigned)(Rb * g.ldb + C * 2); }
    const size_t kstep = (size_t)(BK * 2);
    const size_t hstepA = (size_t)HALF * g.lda, hstepB = (size_t)HALF * g.ldb;
    const size_t tstepA = 2 * hstepA, tstepB = 2 * hstepB;
    const unsigned ldsw = (unsigned)wid * 1024u;
    const int aoff = lds_byte(wr * 64 + fr, fq * 8), boff = lds_byte(wc * 32 + fr, fq * 8);
#define PG8_SA(b, h) (((b) * 2 + (h)) * HTB)
#define PG8_SB(b, h) ((4 + (b) * 2 + (h)) * HTB)
#define PG8_STAGE(bufoff, gbase, voff) do { _Pragma("unroll") for (int _i = 0; _i < 2; ++_i) \
        __builtin_amdgcn_global_load_lds((const unsigned*)((const char*)(gbase) + (voff)[_i]), (LAS unsigned*)(lds + (bufoff) + ldsw + _i * 8192), 16, 0, 0); } while (0)
#define PG8_LD8(p) __builtin_shufflevector(*(const LAS v4i_t*)(p), *(const LAS v4i_t*)((p) + 1024), 0, 1, 2, 3, 4, 5, 6, 7)
#define PG8_LDA(dst, b, h) do { _Pragma("unroll") for (int m = 0; m < 4; ++m) dst[m] = PG8_LD8(lds + PG8_SA(b, h) + aoff + m * 2048); } while (0)
#define PG8_LDB(dst, b, h) do { _Pragma("unroll") for (int n = 0; n < 2; ++n) dst[n] = PG8_LD8(lds + PG8_SB(b, h) + boff + n * 2048); } while (0)
#define PG8_LO(x) __builtin_bit_cast(bf16x8, __builtin_shufflevector((x), (x), 0, 1, 2, 3))
#define PG8_HI(x) __builtin_bit_cast(bf16x8, __builtin_shufflevector((x), (x), 4, 5, 6, 7))
#define PG8_MMA(ai, bj, At, Bt) do { __builtin_amdgcn_s_setprio(1); \
        if constexpr (FP8) { _Pragma("unroll") for (int m = 0; m < 4; ++m) _Pragma("unroll") for (int n = 0; n < 2; ++n) \
            asm volatile("v_mfma_f32_16x16x128_f8f6f4 %0, %1, %2, %0" : "+v"(acc[ai][bj][m][n]) : "v"(Bt[n]), "v"(At[m])); } \
        else { _Pragma("unroll") for (int m = 0; m < 4; ++m) _Pragma("unroll") for (int n = 0; n < 2; ++n) { \
            acc[ai][bj][m][n] = __builtin_amdgcn_mfma_f32_16x16x32_bf16(PG8_LO(Bt[n]), PG8_LO(At[m]), acc[ai][bj][m][n], 0, 0, 0); \
            acc[ai][bj][m][n] = __builtin_amdgcn_mfma_f32_16x16x32_bf16(PG8_HI(Bt[n]), PG8_HI(At[m]), acc[ai][bj][m][n], 0, 0, 0); } } \
        __builtin_amdgcn_s_setprio(0); } while (0)
#define PG8_WAIT_V(n) asm volatile("s_waitcnt vmcnt(" #n ")" ::: "memory")
#define PG8_WAIT_L(n) asm volatile("s_waitcnt lgkmcnt(" #n ")" ::: "memory")
#define PG8_BAR __builtin_amdgcn_s_barrier()
#define PG8_SCHED __builtin_amdgcn_sched_barrier(0)
    Unit cur, nxt; int ui = 0, prep_pm = -1;
    if (!S.next(0, cur)) return;
    f32x4 acc[2][2][4][2];
#pragma unroll
    for (int a = 0; a < 2; ++a)
#pragma unroll
        for (int b = 0; b < 2; ++b)
#pragma unroll
            for (int m = 0; m < 4; ++m)
#pragma unroll
                for (int n = 0; n < 2; ++n) acc[a][b][m][n] = (f32x4){0.f, 0.f, 0.f, 0.f};
    v8i_t At[4], B0[2], B1[2];
    const char* cA = (const char*)g.A + (size_t)cur.pm * tstepA + (size_t)cur.ks * g.kso; const char* cB = (const char*)g.Bt + (size_t)cur.e * g.bgs + (size_t)cur.pn * tstepB + (size_t)cur.ks * g.kso;
    PG8_STAGE(PG8_SB(0, 0), cB, voffB); PG8_STAGE(PG8_SB(0, 1), cB + hstepB, voffB); PG8_STAGE(PG8_SA(0, 0), cA, voffA); PG8_STAGE(PG8_SA(0, 1), cA + hstepA, voffA);
    if (wr == 1) PG8_BAR;
    PG8_WAIT_V(2); PG8_BAR;
    PG8_STAGE(PG8_SB(1, 0), cB + kstep, voffB); PG8_STAGE(PG8_SA(1, 0), cA + kstep, voffA); PG8_STAGE(PG8_SB(1, 1), cB + hstepB + kstep, voffB);
    PG8_WAIT_V(6); PG8_BAR;
    for (;;) {
        const bool has_next = S.next(ui + 1, nxt);
        const char* nA = has_next ? (const char*)g.A + (size_t)nxt.pm * tstepA + (size_t)nxt.ks * g.kso : cA; const char* nB = has_next ? (const char*)g.Bt + (size_t)nxt.e * g.bgs + (size_t)nxt.pn * tstepB + (size_t)nxt.ks * g.kso : cB;
#pragma unroll 1
        for (int t = 0; t < nt; t += 2) {
            const bool last = (t == nt - 2);
            const char* a1 = cA + (size_t)(t + 1) * kstep;
            const char* a2 = last ? nA : cA + (size_t)(t + 2) * kstep; const char* b2 = last ? nB : cB + (size_t)(t + 2) * kstep;
            const char* a3 = a2 + kstep; const char* b3 = b2 + kstep;
            PG8_LDB(B0, 0, 0); PG8_LDB(B1, 0, 1); PG8_SCHED; PG8_LDA(At, 0, 0); PG8_STAGE(PG8_SA(1, 1), a1 + hstepA, voffA);
            PG8_WAIT_V(8); PG8_WAIT_L(0); PG8_BAR; PG8_MMA(0, 0, At, B0); PG8_MMA(0, 1, At, B1); PG8_BAR; PG8_SCHED;
            PG8_LDA(At, 0, 1); PG8_STAGE(PG8_SB(0, 0), b2, voffB); PG8_STAGE(PG8_SB(0, 1), b2 + hstepB, voffB); PG8_STAGE(PG8_SA(0, 0), a2, voffA);
            PG8_WAIT_V(8); PG8_WAIT_L(0); PG8_BAR; PG8_MMA(1, 0, At, B0); PG8_MMA(1, 1, At, B1); PG8_BAR; PG8_SCHED;
            PG8_LDB(B0, 1, 0); PG8_LDB(B1, 1, 1); PG8_SCHED; PG8_LDA(At, 1, 0); PG8_STAGE(PG8_SA(0, 1), a2 + hstepA, voffA);
            PG8_WAIT_V(8); PG8_WAIT_L(0); PG8_BAR; PG8_MMA(0, 0, At, B0); PG8_MMA(0, 1, At, B1); PG8_BAR; PG8_SCHED;
            PG8_LDA(At, 1, 1); PG8_STAGE(PG8_SB(1, 0), b3, voffB); PG8_STAGE(PG8_SB(1, 1), b3 + hstepB, voffB); PG8_STAGE(PG8_SA(1, 0), a3, voffA);
            PG8_WAIT_V(8); PG8_WAIT_L(0); PG8_BAR; PG8_MMA(1, 0, At, B0); PG8_MMA(1, 1, At, B1); PG8_BAR; PG8_SCHED;
        }
        if (wr == 0) PG8_BAR;
        if constexpr (Epi::HAS_PREP) { if (cur.pm != prep_pm) { E.prep(lds + STAGE_BYTES, cur, tid); prep_pm = cur.pm; } }
        if constexpr (FP8) { asm volatile("s_nop 15\n\ts_nop 7" ::: "memory"); PG8_SCHED; }
        E(acc, cur, wr, wc, fr, fq, lds + STAGE_BYTES);
        if (!has_next) break;
#pragma unroll
        for (int a = 0; a < 2; ++a)
#pragma unroll
            for (int b = 0; b < 2; ++b)
#pragma unroll
                for (int m = 0; m < 4; ++m)
#pragma unroll
                    for (int n = 0; n < 2; ++n) acc[a][b][m][n] = (f32x4){0.f, 0.f, 0.f, 0.f};
        cur = nxt; cA = nA; cB = nB; ++ui;
        if (wr == 1) PG8_BAR;
    }
    PG8_WAIT_V(0);
    PG8_BAR;
#undef PG8_SA
#undef PG8_SB
#undef PG8_STAGE
#undef PG8_LDA
#undef PG8_LDB
#undef PG8_MMA
#undef PG8_LO
#undef PG8_HI
#undef PG8_LD8
#undef PG8_WAIT_V
#undef PG8_WAIT_L
#undef PG8_BAR
#undef PG8_SCHED
}
}

namespace att {
struct Unit {
    const bf16_t* q;  long qs;
    const bf16_t* k1; long k1s;
    const bf16_t* k2; long k2s;
    const bf16_t* v;  long vs;
    bf16_t* o; long os;
    float* lse; long lses;
    int q0, kt0, W;
};
__device__ __forceinline__ int crow(int r, int hi) { return (r & 3) + 8 * (r >> 2) + 4 * hi; }
typedef short v4i16_t __attribute__((ext_vector_type(4)));
__device__ __forceinline__ s16x4 vtr(const LAS unsigned char* p) { return __builtin_bit_cast(s16x4, __builtin_amdgcn_ds_read_tr16_b64_v4i16((LAS v4i16_t*)p)); }

constexpr bool ATT_F8O = true; constexpr float ATT_OSC = 16.0f, OM_SC = 16.0f;
template <int DQK, int NGRP> struct Geo {
    static constexpr int WPG = 8 / NGRP, GT = 64 * WPG, KSTR = DQK * 2 + 16, KB = 64 * KSTR, VB = 8192, GRP_BYTES = 2 * KB + 2 * VB, KN = 512 / GT;
};

template <int DQK, int NGRP, bool HAS_LSE>
__device__ __forceinline__ void attn_units(LAS unsigned char* lds, const Unit& U, int nt, bf16x8 (&qf)[DQK / 16], bool first, const Unit& Un, bool has_next) {
    typedef Geo<DQK, NGRP> G;
    const int tid = threadIdx.x, lane = tid & 63, r = lane & 31, h = lane >> 5;
    const int wave = __builtin_amdgcn_readfirstlane(tid >> 6), grp = wave / G::WPG, wg = wave % G::WPG, tg = tid - grp * G::GT;
    LAS unsigned char* gl = lds + grp * G::GRP_BYTES;
    const int qlo = U.q0 + 32 * wg, qhi = qlo + 31, qpos = qlo + r;
    if (first) { const bf16_t* qp = U.q + (long)qpos * U.qs + 8 * h;
#pragma unroll
      for (int d0 = 0; d0 < DQK / 16; ++d0) qf[d0] = *(const bf16x8*)(qp + 16 * d0); }
    bf16x8 qn[DQK / 16];
#pragma unroll
    for (int d0 = 0; d0 < DQK / 16; ++d0) qn[d0] = qf[d0];
    u32x4 rk[G::KN], rv[G::KN], rk2;
    rk2 = (u32x4){0u, 0u, 0u, 0u};
#define ATT_LOADU(UU, t) do { const int kb_ = (UU).kt0 + 64 * (t); \
        _Pragma("unroll") for (int i_ = 0; i_ < G::KN; ++i_) { const int c_ = tg + G::GT * i_, key_ = c_ >> 3, ch_ = c_ & 7; int p_ = kb_ + key_; p_ = p_ < 0 ? 0 : p_; \
            rk[i_] = *(const u32x4*)((UU).k1 + (long)p_ * (UU).k1s + ch_ * 8); rv[i_] = *(const u32x4*)((UU).v + (long)p_ * (UU).vs + ch_ * 8); } \
        if (DQK == 96) { if (tg < 256) { const int key_ = tg >> 2, ch_ = tg & 3; int p_ = kb_ + key_; p_ = p_ < 0 ? 0 : p_; rk2 = *(const u32x4*)((UU).k2 + (long)p_ * (UU).k2s + ch_ * 8); } } } while (0)
#define ATT_LOAD(t) ATT_LOADU(U, t)
#define ATT_WRITE(buf) do { LAS unsigned char* kb_ = gl + (buf) * G::KB; LAS unsigned char* vb_ = gl + 2 * G::KB + (buf) * G::VB; \
        _Pragma("unroll") for (int i_ = 0; i_ < G::KN; ++i_) { const int c_ = tg + G::GT * i_, key_ = c_ >> 3, ch_ = c_ & 7; \
            *(LAS u32x4*)(kb_ + key_ * G::KSTR + ch_ * 16) = rk[i_]; *(LAS u32x4*)(vb_ + (ch_ >> 2) * 4096 + key_ * 64 + (ch_ & 3) * 16) = rv[i_]; } \
        if (DQK == 96) { if (tg < 256) { const int key_ = tg >> 2, ch_ = tg & 3; *(LAS u32x4*)(kb_ + key_ * G::KSTR + 128 + ch_ * 16) = rk2; } } } while (0)
    constexpr float ATT_THR = 8.0f;
    float m_run = 0.f; bool fresh = true;
    f32x16 o0 = {}, o1 = {}, negm = {};
    float l_run = 0.f;
    f32x16 maskR;
#pragma unroll
    for (int i = 0; i < 16; ++i) maskR[i] = (crow(i, h) <= r) ? 0.f : -INFINITY;
    const int trow = ((lane & 15) >> 2), tcol = ((lane >> 4) & 1) * 32 + (lane & 3) * 8;
    if (first) { ATT_LOAD(0); ATT_WRITE(0); __syncthreads(); }
    if (wave >= 4) __builtin_amdgcn_s_setprio(1);
    for (int t = 0; t < nt; ++t) {
        if (t + 1 < nt) ATT_LOAD(t + 1);
        else if (has_next) { ATT_LOADU(Un, 0); const bf16_t* qp = Un.q + (long)(Un.q0 + 32 * wg + r) * Un.qs + 8 * h;
#pragma unroll
            for (int d0 = 0; d0 < DQK / 16; ++d0) qn[d0] = *(const bf16x8*)(qp + 16 * d0); }
        const LAS unsigned char* Kb = gl + (t & 1) * G::KB; const LAS unsigned char* Vb = gl + 2 * G::KB + (t & 1) * G::VB;
        const int kb = U.kt0 + 64 * t;
        if (!(kb > qhi || kb + 63 < qlo - U.W || kb + 63 < 0)) {
            f32x16 s0 = negm, s1 = negm;
            if (kb + 63 > qlo) { if (kb == qlo) { s0 = negm + maskR; s1 = negm - INFINITY; } else s1 = negm + maskR; }
            const LAS unsigned char* kp = Kb + r * G::KSTR + 16 * h;
#pragma unroll
            for (int d0 = 0; d0 < DQK / 16; ++d0) { const bf16x8 kf0 = *(const LAS bf16x8*)(kp + 32 * d0), kf1 = *(const LAS bf16x8*)(kp + 32 * G::KSTR + 32 * d0);
                s0 = __builtin_amdgcn_mfma_f32_32x32x16_bf16(kf0, qf[d0], s0, 0, 0, 0); s1 = __builtin_amdgcn_mfma_f32_32x32x16_bf16(kf1, qf[d0], s1, 0, 0, 0); }
            float mx = fmaxf(fmaxf(s0[0], s0[1]), s0[2]), my = fmaxf(fmaxf(s1[0], s1[1]), s1[2]);
#pragma unroll
            for (int i = 3; i < 15; i += 2) { mx = fmaxf(fmaxf(mx, s0[i]), s0[i + 1]); my = fmaxf(fmaxf(my, s1[i]), s1[i + 1]); }
            mx = fmaxf(fmaxf(mx, s0[15]), fmaxf(my, s1[15]));
            { auto rr = __builtin_amdgcn_permlane32_swap(__float_as_uint(mx), __float_as_uint(mx), false, false); mx = fmaxf(__uint_as_float(rr[0]), __uint_as_float(rr[1])); }
            float dl = fresh ? mx : ((mx > ATT_THR) ? mx : 0.f);
            dl = (dl == -INFINITY) ? 0.f : dl;
            if (__any(dl != 0.f)) {
                m_run += dl; const float alpha = __builtin_amdgcn_exp2f(-dl);
#pragma unroll
                for (int i = 0; i < 16; ++i) { s0[i] -= dl; s1[i] -= dl; o0[i] *= alpha; o1[i] *= alpha; negm[i] = -m_run; }
                l_run *= alpha;
            }
            fresh = false;
#pragma unroll
            for (int i = 0; i < 16; ++i) { s0[i] = __builtin_amdgcn_exp2f(s0[i]); s1[i] = __builtin_amdgcn_exp2f(s1[i]); }
            { f32x2 a2 = {0.f, 0.f};
#pragma unroll
              for (int i = 0; i < 16; i += 2) a2 += (f32x2){s0[i], s0[i + 1]} + (f32x2){s1[i], s1[i + 1]};
              l_run += a2[0] + a2[1]; }
            bf16x8 pf[4];
#pragma unroll
            for (int s2 = 0; s2 < 2; ++s2) { u32x4 w; w.x = pk2(s0[8 * s2], s0[8 * s2 + 1]); w.y = pk2(s0[8 * s2 + 2], s0[8 * s2 + 3]); w.z = pk2(s0[8 * s2 + 4], s0[8 * s2 + 5]); w.w = pk2(s0[8 * s2 + 6], s0[8 * s2 + 7]);
                pf[s2] = __builtin_bit_cast(bf16x8, w);
                u32x4 x; x.x = pk2(s1[8 * s2], s1[8 * s2 + 1]); x.y = pk2(s1[8 * s2 + 2], s1[8 * s2 + 3]); x.z = pk2(s1[8 * s2 + 4], s1[8 * s2 + 5]); x.w = pk2(s1[8 * s2 + 6], s1[8 * s2 + 7]);
                pf[2 + s2] = __builtin_bit_cast(bf16x8, x); }
#pragma unroll
            for (int s2 = 0; s2 < 4; ++s2) {
                const LAS unsigned char* vp = Vb + (16 * s2 + 4 * h + trow) * 64 + tcol;
                const s16x4 a0 = vtr(vp), a1 = vtr(vp + 8 * 64), b0 = vtr(vp + 4096), b1 = vtr(vp + 4096 + 8 * 64);
                const bf16x8 vf0 = (bf16x8){a0[0], a0[1], a0[2], a0[3], a1[0], a1[1], a1[2], a1[3]};
                const bf16x8 vf1 = (bf16x8){b0[0], b0[1], b0[2], b0[3], b1[0], b1[1], b1[2], b1[3]};
                o0 = __builtin_amdgcn_mfma_f32_32x32x16_bf16(vf0, pf[s2], o0, 0, 0, 0);
                o1 = __builtin_amdgcn_mfma_f32_32x32x16_bf16(vf1, pf[s2], o1, 0, 0, 0);
            }
        }
        if (t + 1 < nt) ATT_WRITE((t + 1) & 1); else if (has_next) ATT_WRITE(0);
        __syncthreads();
    }
#undef ATT_LOAD
#undef ATT_LOADU
#undef ATT_WRITE
    __builtin_amdgcn_s_setprio(0);
    float l_tot; { auto rr = __builtin_amdgcn_permlane32_swap(__float_as_uint(l_run), __float_as_uint(l_run), false, false); l_tot = __uint_as_float(rr[0]) + __uint_as_float(rr[1]); }
    const float inv = 1.0f / l_tot;
    if constexpr (ATT_F8O) {
        const float is = inv * ATT_OSC; unsigned char* op = (unsigned char*)U.o + (long)qpos * U.os + 16 * h;
        unsigned w0[4], w1[4];
#pragma unroll
        for (int g4 = 0; g4 < 4; ++g4) {
            w0[g4] = pk4f8(fclamp8(o0[4 * g4] * is), fclamp8(o0[4 * g4 + 1] * is), fclamp8(o0[4 * g4 + 2] * is), fclamp8(o0[4 * g4 + 3] * is));
            w1[g4] = pk4f8(fclamp8(o1[4 * g4] * is), fclamp8(o1[4 * g4 + 1] * is), fclamp8(o1[4 * g4 + 2] * is), fclamp8(o1[4 * g4 + 3] * is)); }
        const auto a0 = __builtin_amdgcn_permlane32_swap(w0[0], w0[2], false, false), a1 = __builtin_amdgcn_permlane32_swap(w0[1], w0[3], false, false);
        const auto b0 = __builtin_amdgcn_permlane32_swap(w1[0], w1[2], false, false), b1 = __builtin_amdgcn_permlane32_swap(w1[1], w1[3], false, false);
        *(u32x4*)op = (u32x4){a0[0], a0[1], a1[0], a1[1]};
        *(u32x4*)(op + 32) = (u32x4){b0[0], b0[1], b1[0], b1[1]};
    } else {
    bf16_t* op = U.o + (long)qpos * U.os + 4 * h;
#pragma unroll
    for (int g4 = 0; g4 < 4; ++g4) {
        u32x2 w0, w1;
        w0.x = pk2(o0[4 * g4] * inv, o0[4 * g4 + 1] * inv); w0.y = pk2(o0[4 * g4 + 2] * inv, o0[4 * g4 + 3] * inv);
        w1.x = pk2(o1[4 * g4] * inv, o1[4 * g4 + 1] * inv); w1.y = pk2(o1[4 * g4 + 2] * inv, o1[4 * g4 + 3] * inv);
        *(u32x2*)(op + 8 * g4) = w0; *(u32x2*)(op + 32 + 8 * g4) = w1;
    }
    }
    if (HAS_LSE) { if (h == 0) U.lse[(long)qpos * U.lses] = m_run + log2f(l_tot); }
#pragma unroll
    for (int d0 = 0; d0 < DQK / 16; ++d0) qf[d0] = qn[d0];
}

constexpr int DSW_KSTR = 144, DSW_KB = 256 * DSW_KSTR, DSW_VB = 4 * 8192, DSW_GRP = DSW_KB + DSW_VB;
struct DswTensors { const unsigned char* KVQ; unsigned char* OG; float* LSE; };
struct DswUnit { const unsigned char* q; const unsigned char* k; const unsigned char* v; long st; unsigned char* o; long os; float* lse; long lses; int q0, kt0, slot; bool ldprev; };
__device__ __forceinline__ u32x4 f8x8_bf16(unsigned lo, unsigned hi, float sc) {
    const f32x2 a = __builtin_amdgcn_cvt_pk_f32_fp8(lo, false), b = __builtin_amdgcn_cvt_pk_f32_fp8(lo, true), c = __builtin_amdgcn_cvt_pk_f32_fp8(hi, false), d = __builtin_amdgcn_cvt_pk_f32_fp8(hi, true);
    u32x4 w; w.x = pk2(a.x * sc, a.y * sc); w.y = pk2(b.x * sc, b.y * sc); w.z = pk2(c.x * sc, c.y * sc); w.w = pk2(d.x * sc, d.y * sc); return w;
}
__device__ __forceinline__ void dsw_unit(int s, int grp, bool first, const DswTensors& T, DswUnit& U) {
    const int bgh = s >> 3, b = bgh / 48, gbr = (bgh / 16) % 3, hh = bgh & 15, ju = 8 * grp + (s & 7);
    const int dil = gbr == 0 ? 1 : (gbr == 1 ? 4 : 16);
    const int rr = gbr == 0 ? 0 : (gbr == 1 ? (ju >> 2) : ju), nb = gbr == 0 ? ju : (gbr == 1 ? (ju & 3) : 0);
    const size_t rowb = (size_t)b * SEQ + rr;
    { const size_t part = (size_t)3 * BATCH * 16 * SEQ * 64, blk = ((size_t)((gbr * BATCH + b) * 16 + hh) * SEQ + (size_t)rr * (SEQ / dil)) * 64;
      U.k = T.KVQ + blk; U.v = U.k + part; U.q = U.k + 2 * part; U.st = 64; }
    U.o = T.OG + (size_t)gbr * M * D + rowb * D + hh * 64; U.os = (long)dil * D;
    U.lse = T.LSE + (size_t)gbr * M * 16 + rowb * 16 + hh; U.lses = (long)dil * 16;
    U.q0 = 128 * nb; U.kt0 = 128 * (nb - 1);
    U.slot = nb & 1; U.ldprev = (nb > 0) && (first || (s & 7) == 0);
}
struct DswRegs { u32x4 rk[4], rv[4]; u32x2 qn[4]; int q0, kt0, slot; bool ldprev; unsigned char* o; long os; float* lse; long lses; };
struct DswCur { bf16x8 qf[4]; int q0, kt0, slot; unsigned char* o; long os; float* lse; long lses; };
__device__ __forceinline__ void dsw_load(DswRegs& R, int s, int grp, bool first, const DswTensors& T, int tg, int wg, int r, int h) {
    DswUnit U; dsw_unit(s, grp, first, T, U);
#pragma unroll
    for (int i = 0; i < 2; ++i) { const int key = (tg >> 2) + 64 * i, ch = tg & 3; const int p = U.q0 + key;
        R.rk[i] = __builtin_nontemporal_load((const u32x4*)(U.k + (long)p * U.st + ch * 16)); R.rv[i] = __builtin_nontemporal_load((const u32x4*)(U.v + (long)p * U.st + ch * 16)); }
    if (U.ldprev) {
#pragma unroll
        for (int i = 0; i < 2; ++i) { const int key = (tg >> 2) + 64 * i, ch = tg & 3; const int p = U.kt0 + key;
            R.rk[2 + i] = *(const u32x4*)(U.k + (long)p * U.st + ch * 16); R.rv[2 + i] = *(const u32x4*)(U.v + (long)p * U.st + ch * 16); }
    }
    const unsigned char* qp = U.q + (long)(U.q0 + 32 * wg + r) * U.st + 8 * h;
#pragma unroll
    for (int d0 = 0; d0 < 4; ++d0) R.qn[d0] = __builtin_nontemporal_load((const u32x2*)(qp + 16 * d0));
    R.q0 = U.q0; R.kt0 = U.kt0; R.slot = U.slot; R.ldprev = U.ldprev; R.o = U.o; R.os = U.os; R.lse = U.lse; R.lses = U.lses;
}
__device__ __forceinline__ void dsw_stage(const DswRegs& R, DswCur& C, LAS unsigned char* Kb, LAS unsigned char* Vb, int tg) {
#pragma unroll
    for (int i = 0; i < 2; ++i) { const int key = (tg >> 2) + 64 * i, ch = tg & 3;
        LAS u32x4* kd = (LAS u32x4*)(Kb + (R.slot * 128 + key) * DSW_KSTR + ch * 32); kd[0] = f8x8_bf16(R.rk[i].x, R.rk[i].y, 1.0f); kd[1] = f8x8_bf16(R.rk[i].z, R.rk[i].w, 1.0f);
        LAS u32x4* vd = (LAS u32x4*)(Vb + (R.slot * 2 + i) * 8192 + (ch >> 1) * 4096 + (key & 63) * 64 + (ch & 1) * 32); vd[0] = f8x8_bf16(R.rv[i].x, R.rv[i].y, 1.0f); vd[1] = f8x8_bf16(R.rv[i].z, R.rv[i].w, 1.0f); }
    if (R.ldprev) {
#pragma unroll
        for (int i = 0; i < 2; ++i) { const int key = (tg >> 2) + 64 * i, ch = tg & 3; const int ps = R.slot ^ 1;
            LAS u32x4* kd = (LAS u32x4*)(Kb + (ps * 128 + key) * DSW_KSTR + ch * 32); kd[0] = f8x8_bf16(R.rk[2 + i].x, R.rk[2 + i].y, 1.0f); kd[1] = f8x8_bf16(R.rk[2 + i].z, R.rk[2 + i].w, 1.0f);
            LAS u32x4* vd = (LAS u32x4*)(Vb + (ps * 2 + i) * 8192 + (ch >> 1) * 4096 + (key & 63) * 64 + (ch & 1) * 32); vd[0] = f8x8_bf16(R.rv[2 + i].x, R.rv[2 + i].y, 1.0f); vd[1] = f8x8_bf16(R.rv[2 + i].z, R.rv[2 + i].w, 1.0f); }
    }
#pragma unroll
    for (int d0 = 0; d0 < 4; ++d0) C.qf[d0] = __builtin_bit_cast(bf16x8, f8x8_bf16(R.qn[d0].x, R.qn[d0].y, QSCALE_DSW));
    C.q0 = R.q0; C.kt0 = R.kt0; C.slot = R.slot; C.o = R.o; C.os = R.os; C.lse = R.lse; C.lses = R.lses;
}
__device__ __forceinline__ void dsw_compute(const DswCur& C, const LAS unsigned char* Kb, const LAS unsigned char* Vb, int wg, int r, int h, int trow, int tcol, const f32x16& maskL, const f32x16& maskR) {
    const int q0 = C.q0, kt0 = C.kt0;
    const int qlo = q0 + 32 * wg, qhi = qlo + 31, qpos = qlo + r;
    constexpr float DSW_THR = 8.0f;
    float m_run = 0.f; bool fresh = true;
    f32x16 o0 = {}, o1 = {}, negm = {};
    float l_run = 0.f;
#pragma unroll 1
    for (int sub = 0; sub < 8; ++sub) {
        const int kb = kt0 + 32 * sub;
        if (kb > qhi || kb + 31 < qlo - 128 || kb + 31 < 0) continue;
        f32x16 sc = negm;
        if (sub == wg) sc = negm + maskL; else if (sub == wg + 4) sc = negm + maskR;
        const int half = (sub < 4) ? (C.slot ^ 1) : C.slot;
        const LAS unsigned char* kp = Kb + (128 * half + 32 * (sub & 3) + r) * DSW_KSTR + 16 * h;
#pragma unroll
        for (int d0 = 0; d0 < 4; ++d0) { const bf16x8 kf = *(const LAS bf16x8*)(kp + 32 * d0); sc = __builtin_amdgcn_mfma_f32_32x32x16_bf16(kf, C.qf[d0], sc, 0, 0, 0); }
        float mx = fmaxf(fmaxf(sc[0], sc[1]), sc[2]), my = fmaxf(fmaxf(sc[3], sc[4]), sc[5]);
#pragma unroll
        for (int i = 6; i < 14; i += 4) { mx = fmaxf(fmaxf(mx, sc[i]), sc[i + 1]); my = fmaxf(fmaxf(my, sc[i + 2]), sc[i + 3]); }
        mx = fmaxf(fmaxf(mx, sc[14]), fmaxf(my, sc[15]));
        { auto rr = __builtin_amdgcn_permlane32_swap(__float_as_uint(mx), __float_as_uint(mx), false, false); mx = fmaxf(__uint_as_float(rr[0]), __uint_as_float(rr[1])); }
        float dl = fresh ? mx : ((mx > DSW_THR) ? mx : 0.f);
        dl = (dl == -INFINITY) ? 0.f : dl;
        if (__any(dl != 0.f)) {
            m_run += dl; const float alpha = __builtin_amdgcn_exp2f(-dl);
#pragma unroll
            for (int i = 0; i < 16; ++i) { sc[i] -= dl; o0[i] *= alpha; o1[i] *= alpha; negm[i] = -m_run; }
            l_run *= alpha;
        }
        fresh = false;
#pragma unroll
        for (int i = 0; i < 16; ++i) sc[i] = __builtin_amdgcn_exp2f(sc[i]);
        { f32x2 a2 = {0.f, 0.f};
#pragma unroll
          for (int i = 0; i < 16; i += 4) a2 += (f32x2){sc[i], sc[i + 1]} + (f32x2){sc[i + 2], sc[i + 3]};
          l_run += a2[0] + a2[1]; }
        bf16x8 pf[2];
#pragma unroll
        for (int s2 = 0; s2 < 2; ++s2) { u32x4 w; w.x = pk2(sc[8 * s2], sc[8 * s2 + 1]); w.y = pk2(sc[8 * s2 + 2], sc[8 * s2 + 3]); w.z = pk2(sc[8 * s2 + 4], sc[8 * s2 + 5]); w.w = pk2(sc[8 * s2 + 6], sc[8 * s2 + 7]);
            pf[s2] = __builtin_bit_cast(bf16x8, w); }
#pragma unroll
        for (int s2 = 0; s2 < 2; ++s2) {
            const LAS unsigned char* vp = Vb + (2 * half + ((sub >> 1) & 1)) * 8192 + (32 * (sub & 1) + 16 * s2 + 4 * h + trow) * 64 + tcol;
            const s16x4 a0 = vtr(vp), a1 = vtr(vp + 8 * 64), b0 = vtr(vp + 4096), b1 = vtr(vp + 4096 + 8 * 64);
            const bf16x8 vf0 = (bf16x8){a0[0], a0[1], a0[2], a0[3], a1[0], a1[1], a1[2], a1[3]};
            const bf16x8 vf1 = (bf16x8){b0[0], b0[1], b0[2], b0[3], b1[0], b1[1], b1[2], b1[3]};
            o0 = __builtin_amdgcn_mfma_f32_32x32x16_bf16(vf0, pf[s2], o0, 0, 0, 0);
            o1 = __builtin_amdgcn_mfma_f32_32x32x16_bf16(vf1, pf[s2], o1, 0, 0, 0);
        }
    }
    float l_tot; { auto rr = __builtin_amdgcn_permlane32_swap(__float_as_uint(l_run), __float_as_uint(l_run), false, false); l_tot = __uint_as_float(rr[0]) + __uint_as_float(rr[1]); }
    const float inv = 1.0f / l_tot;
    unsigned char* op = C.o + (long)qpos * C.os + 16 * h;
    {
        unsigned w0[4], w1[4];
#pragma unroll
        for (int g4 = 0; g4 < 4; ++g4) { w0[g4] = pk4f8(o0[4 * g4] * inv, o0[4 * g4 + 1] * inv, o0[4 * g4 + 2] * inv, o0[4 * g4 + 3] * inv); w1[g4] = pk4f8(o1[4 * g4] * inv, o1[4 * g4 + 1] * inv, o1[4 * g4 + 2] * inv, o1[4 * g4 + 3] * inv); }
        const auto a0 = __builtin_amdgcn_permlane32_swap(w0[0], w0[2], false, false), a1 = __builtin_amdgcn_permlane32_swap(w0[1], w0[3], false, false);
        const auto b0 = __builtin_amdgcn_permlane32_swap(w1[0], w1[2], false, false), b1 = __builtin_amdgcn_permlane32_swap(w1[1], w1[3], false, false);
        *(u32x4*)op = (u32x4){a0[0], a0[1], a1[0], a1[1]};
        *(u32x4*)(op + 32) = (u32x4){b0[0], b0[1], b1[0], b1[1]};
    }
    if (h == 0) C.lse[(long)qpos * C.lses] = m_run + log2f(l_tot);
}
__device__ __forceinline__ void dsw_phase(LAS unsigned char* lds, const DswTensors& T, int vcu, int G) {
    const int tid = threadIdx.x, lane = tid & 63, r = lane & 31, h = lane >> 5;
    const int wave = __builtin_amdgcn_readfirstlane(tid >> 6), grp = wave >> 2, wg = wave & 3, tg = tid & 255;
    LAS unsigned char* Kb = lds + grp * DSW_GRP; LAS unsigned char* Vb = Kb + DSW_KB;
    const int nv = (256 - vcu + G - 1) / G, nst = 12 * nv;
    const int trow = ((lane & 15) >> 2), tcol = ((lane >> 4) & 1) * 32 + (lane & 3) * 8;
    DswRegs A, B; DswCur C;
    f32x16 maskL, maskR;
#pragma unroll
    for (int i = 0; i < 16; ++i) { const int c = crow(i, h); maskL[i] = (c >= r) ? 0.f : -INFINITY; maskR[i] = (c <= r) ? 0.f : -INFINITY; }
#define DSW_STEP(i_) ((vcu + ((i_) / 12) * G) * 12 + (i_) % 12)
#define DSW_FIRST(i_) (((i_) % 12) == 0)
    if (nst > 0) { dsw_load(A, DSW_STEP(0), grp, DSW_FIRST(0), T, tg, wg, r, h); dsw_load(B, DSW_STEP(1), grp, DSW_FIRST(1), T, tg, wg, r, h); }
    if (wave >= 4) __builtin_amdgcn_s_setprio(1);
    for (int st = 0; st < nst; st += 2) {
        dsw_stage(A, C, Kb, Vb, tg);
        __syncthreads();
        if (st + 2 < nst) dsw_load(A, DSW_STEP(st + 2), grp, DSW_FIRST(st + 2), T, tg, wg, r, h);
        dsw_compute(C, Kb, Vb, wg, r, h, trow, tcol, maskL, maskR);
        __syncthreads();
        dsw_stage(B, C, Kb, Vb, tg);
        __syncthreads();
        if (st + 3 < nst) dsw_load(B, DSW_STEP(st + 3), grp, DSW_FIRST(st + 3), T, tg, wg, r, h);
        dsw_compute(C, Kb, Vb, wg, r, h, trow, tcol, maskL, maskR);
        __syncthreads();
    }
    __builtin_amdgcn_s_setprio(0);
#undef DSW_STEP
#undef DSW_FIRST
}
}

constexpr size_t MiB = 1u << 20;
constexpr size_t WS_CTL = 0, CTL_ZERO_BYTES = 65536;
constexpr size_t WS_ROPEA = 1 * MiB, WS_ROPEB = 3 * MiB, WS_MISC = 4 * MiB;
constexpr size_t MISC_RG = 0, MISC_TOKE = 64 * 1024, MISC_TOKG = 192 * 1024, MISC_TOKS = 320 * 1024, MISC_CNT = 448 * 1024, MISC_TILEE = 512 * 1024, MISC_NT = 520 * 1024, MISC_INV0 = 576 * 1024;
constexpr size_t WS_WD = 5 * MiB, WS_WUQ = WS_WD + 1536 * 1024, WS_WUKV = WS_WUQ + 1152 * 1024, WS_WO = WS_WUKV + 1 * MiB, WS_WGU = WS_WO + 2 * MiB, WS_WDN = WS_WGU + 11 * MiB,
                 WS_WKVQ = WS_WDN + 5632 * 1024, WS_WO2 = WS_WKVQ + 18 * MiB, WS_WEND = WS_WO2 + 2 * MiB;
static_assert(WS_WEND <= 48 * MiB, "weights region");
constexpr size_t WS_XN = 48 * MiB;
constexpr size_t WS_DOWN = 80 * MiB, WS_CQ = 104 * MiB, WS_CKV = 116 * MiB, WS_KR = 124 * MiB, WS_Q = 128 * MiB, WS_KV = 176 * MiB, WS_O = 240 * MiB;
constexpr size_t WS_HID = 80 * MiB;
constexpr size_t WS_KVQ = 80 * MiB, WS_OG = 224 * MiB, WS_LSE = 320 * MiB;
constexpr size_t WS_WGUE = 324 * MiB, WS_WDNE = 380 * MiB, WS_SSQ1 = 408 * MiB, WS_SSQ2 = 409 * MiB, WS_X8 = 410 * MiB, WS_OM = 426 * MiB, WS_END = 458 * MiB;
constexpr size_t WS_HN3 = 80 * MiB, WS_XG = 96 * MiB, WS_YB = 130 * MiB, WS_HIDE = 198 * MiB, WS_YT = 96 * MiB;
static_assert(WS_HIDE + (size_t)RMAX * EF <= WS_WGUE && WS_XG + (size_t)RMAX * D <= WS_YB && WS_YB + (size_t)RMAX * D * 2 <= WS_HIDE && WS_WGUE + (size_t)NE * EGU_N * D <= WS_WDNE && WS_WDNE + (size_t)NE * D * EF <= WS_SSQ1 && WS_HN3 + (size_t)M * D <= WS_XG
              && WS_KVQ + (size_t)M * KVQ_N <= WS_OG && WS_OG + (size_t)3 * M * D * 2 <= WS_LSE && WS_LSE + (size_t)3 * M * 16 * 4 <= WS_WGUE && WS_O + (size_t)M * D * 2 <= WS_WGUE, "workspace map");
constexpr int P12_ROWS_OFF = 40960;
constexpr int P15_MAIN = 128, P15_NS = 7, YT_ROWS = RMAX - P15_MAIN * 256;
constexpr float WSC1 = 32.0f, WSC2 = 64.0f, HSC = 4.0f, YSC = 16.0f;
constexpr int CW_TMO = 0, CW_RDY = 64, CW_BAR = 4096;

constexpr int RING_BYTES = 131072, LDS_BYTES = 147456, LDSCTL_OFF = LDS_BYTES - 1024, MISC_OFF = LDSCTL_OFF + 320;
constexpr int SCR_OFF = 36864, SCR_WAVE = 8704;

#define XB_TMO      128
#define XB_XCNT(j)  (256  + 64 * (j))
#define XB_XSUB(j)  (1280 + 64 * (j))
#define XB_XGEN(j)  (2304 + 64 * (j))
#define XB_TOP      3328
#define XB_TOPGEN   3392
#define XCD_BAR_WORDS 3456
#define XB_LSUB(j)  (3456 + 64 * (j))
#define XB_LGEN(j)  (4480 + 64 * (j))
#define XB_SPIN_CAP (1u << 18)
__device__ __forceinline__ unsigned xb_ld(unsigned* p)              { return __hip_atomic_load(p, __ATOMIC_RELAXED, __HIP_MEMORY_SCOPE_AGENT); }
__device__ __forceinline__ unsigned xb_add(unsigned* p, unsigned v) { return __hip_atomic_fetch_add(p, v, __ATOMIC_RELAXED, __HIP_MEMORY_SCOPE_AGENT); }
__device__ __forceinline__ unsigned xb_xcc_id() { return (unsigned)__builtin_amdgcn_s_getreg((3 << 11) | 20) & 0xFu; }
#define XB_SPIN(cond, bar) do { unsigned _sp = 0; while (cond) { __builtin_amdgcn_s_sleep(1); \
    if ((++_sp & 255u) == 0u) { if (xb_ld(&(bar)[XB_TMO])) break; if (_sp > XB_SPIN_CAP) { atomicAdd(&(bar)[XB_TMO], 1u); break; } } } } while (0)
struct XcdBarrier { unsigned* bar; unsigned x; volatile LAS unsigned* st; };
__device__ __forceinline__ XcdBarrier xcd_barrier_post(unsigned* bar, volatile LAS unsigned* st) {
    XcdBarrier b; b.bar = bar; b.x = xb_xcc_id(); b.st = st;
    if (threadIdx.x == 0) st[2] = xb_add(&bar[XB_XCNT(b.x)], 1u);
    return b;
}
__device__ __forceinline__ void xcd_barrier_complete(unsigned* bar, unsigned x, unsigned& nloc, unsigned& nx) {
    const unsigned G = gridDim.x * gridDim.y * gridDim.z;
    unsigned sum, cnt, mine, sp = 0u;
    for (;;) {
        sum = 0u; cnt = 0u; mine = 0u;
#pragma unroll
        for (unsigned j = 0; j < 16; ++j) { const unsigned c = xb_ld(&bar[XB_XCNT(j)]); sum += c; cnt += (c > 0u) ? 1u : 0u; mine = (j == x) ? c : mine; }
        if (sum == G) break;
        __builtin_amdgcn_s_sleep(1);
        if ((++sp & 255u) == 0u) { if (xb_ld(&bar[XB_TMO])) break; if (sp > XB_SPIN_CAP) { atomicAdd(&bar[XB_TMO], 1u); break; } }
    }
    nloc = mine > 0u ? mine : 1u; nx = cnt > 0u ? cnt : 1u;
}
__device__ __forceinline__ unsigned xcd_even_index(unsigned* bar, unsigned x) {
    unsigned ok = (gridDim.x * gridDim.y * gridDim.z == 256u) ? 1u : 0u, xi = 0u, cnt = 0u;
#pragma unroll
    for (unsigned j = 0; j < 16; ++j) { const unsigned c = xb_ld(&bar[XB_XCNT(j)]); if (c != 0u && c != 32u) ok = 0u; cnt += (c > 0u) ? 1u : 0u; xi += (j < x && c > 0u) ? 1u : 0u; }
    return (ok != 0u && cnt == 8u) ? 1u + xi : 0u;
}
__device__ __forceinline__ void xcd_barrier(const XcdBarrier& b) {
    asm volatile("s_waitcnt vmcnt(0)" ::: "memory");
    __syncthreads();
    if (threadIdx.x == 0) {
        unsigned* bar = b.bar;
        __builtin_amdgcn_s_waitcnt(0);
        unsigned nloc = b.st[0], nx = b.st[1];
        if (nloc == 0u) { xcd_barrier_complete(bar, b.x, nloc, nx); b.st[0] = nloc; b.st[1] = nx; b.st[3] = xcd_even_index(bar, b.x); }
        const unsigned old = xb_add(&bar[XB_XSUB(b.x)], 1u);
        const unsigned gen = old / nloc;
        if (old + 1u == (gen + 1u) * nloc) {
            __builtin_amdgcn_fence(__ATOMIC_RELEASE, "agent");
            asm volatile("s_waitcnt vmcnt(0)" ::: "memory");
            const unsigned og = xb_add(&bar[XB_TOP], 1u);
            const unsigned tg = og / nx;
            if (og + 1u == (tg + 1u) * nx) xb_add(&bar[XB_TOPGEN], 1u);
            else XB_SPIN(xb_ld(&bar[XB_TOPGEN]) == tg, bar);
            __builtin_amdgcn_fence(__ATOMIC_ACQUIRE, "agent");
            xb_add(&bar[XB_XGEN(b.x)], 1u);
            asm volatile("s_waitcnt vmcnt(0)" ::: "memory");
        } else {
            XB_SPIN(xb_ld(&bar[XB_XGEN(b.x)]) == gen, bar);
            __builtin_amdgcn_fence(__ATOMIC_ACQUIRE, "agent");
            asm volatile("s_waitcnt vmcnt(0)" ::: "memory");
        }
    }
    __syncthreads();
}

__device__ __forceinline__ void xcd_barrier_local(const XcdBarrier& b) {
    asm volatile("s_waitcnt vmcnt(0)" ::: "memory");
    __syncthreads();
    if (threadIdx.x == 0) {
        unsigned* bar = b.bar;
        __builtin_amdgcn_s_waitcnt(0);
        const unsigned old = xb_add(&bar[XB_LSUB(b.x)], 1u), target = (old | 31u) + 1u;
        if ((old & 31u) != 31u) XB_SPIN(xb_ld(&bar[XB_LSUB(b.x)]) < target, bar);
        __builtin_amdgcn_fence(__ATOMIC_ACQUIRE, "agent");
        asm volatile("s_waitcnt vmcnt(0)" ::: "memory");
    }
    __syncthreads();
}

__device__ __forceinline__ int dmap(int mode, int n) {
    switch (mode) {
        default: return n;
        case 1: { if (n < 640) return n; const int i = n - 640; return 640 + (i < 16 ? 2 * i : 2 * (i - 16) + 1); }
        case 2: { const int hh = n / 96, d = n - 96 * hh; if (d < 64) return n; const int i = d - 64; return 96 * hh + 64 + (i < 16 ? 2 * i : 2 * (i - 16) + 1); }
        case 3: return (n >> 7) * 256 + (n & 127);
        case 4: { const int d = n & 63; if (d >= 16) return n; return (n - d) + (d < 8 ? 2 * d : 2 * (d - 8) + 1); }
        case 5: { if (n >= 3072) return n; const int d = n & 63; if (d >= 16) return n; return (n - d) + (d < 8 ? 2 * d : 2 * (d - 8) + 1); }
    }
}
template <bool F8>
__device__ __forceinline__ void tr_item(const float* W, int K, int N, const float* gain, float wsc, void* WT, int mode, int row_off, int item, int lane) {
    const int nblk = N >> 5, kb = item / nblk, nb = item - kb * nblk, k0 = 128 * kb, n0 = 32 * nb;
    const int n4 = lane & 7, kc = lane >> 3;
    const float* src = W + (size_t)(k0 + 16 * kc) * N + n0 + 4 * n4;
    f32x4 v[16];
#pragma unroll
    for (int kk = 0; kk < 16; ++kk) v[kk] = __builtin_nontemporal_load((const f32x4*)(src + (size_t)kk * N));
    float gv[16];
#pragma unroll
    for (int q = 0; q < 4; ++q) { const f32x4 g4 = gain ? *(const f32x4*)(gain + k0 + 16 * kc + 4 * q) : (f32x4){1.f, 1.f, 1.f, 1.f}; gv[4 * q] = g4[0] * wsc; gv[4 * q + 1] = g4[1] * wsc; gv[4 * q + 2] = g4[2] * wsc; gv[4 * q + 3] = g4[3] * wsc; }
#pragma unroll
    for (int j = 0; j < 4; ++j) {
        const size_t n = (size_t)(dmap(mode, n0 + 4 * n4 + j) + row_off);
        if (F8) { u32x4 o;
#pragma unroll
            for (int q = 0; q < 4; ++q) o[q] = pk4f8(fclamp8(v[4 * q][j] * gv[4 * q]), fclamp8(v[4 * q + 1][j] * gv[4 * q + 1]), fclamp8(v[4 * q + 2][j] * gv[4 * q + 2]), fclamp8(v[4 * q + 3][j] * gv[4 * q + 3]));
            *(u32x4*)((unsigned char*)WT + n * K + k0 + 16 * kc) = o; }
        else { u32x4 o0, o1;
#pragma unroll
            for (int q = 0; q < 4; ++q) { o0[q] = pk2(v[2 * q][j] * gv[2 * q], v[2 * q + 1][j] * gv[2 * q + 1]); o1[q] = pk2(v[8 + 2 * q][j] * gv[8 + 2 * q], v[9 + 2 * q][j] * gv[9 + 2 * q]); }
            u32x4* dst = (u32x4*)((bf16_t*)WT + n * K + k0 + 16 * kc); dst[0] = o0; dst[1] = o1; }
    }
}
constexpr int I_E = (D / 128) * (EF / 32), I_ED = (EF / 128) * (D / 32), MOE_ITEMS = NE * (2 * I_E + I_ED), MOE_TAIL = NE * I_ED - 1536, P14_IA = 28;
__device__ __forceinline__ void moe_conv_item(int it, const float* wg, const float* wu, const float* wd, const float* gain, unsigned char* WGUE, unsigned char* WDNE, int lane) {
    int e, r;
    if (it < NE * 2 * I_E) { e = it / (2 * I_E); r = it % (2 * I_E); } else { const int t = it - NE * 2 * I_E; e = t / I_ED; r = 2 * I_E + t % I_ED; }
    if (r < I_E) tr_item<true>(wg + (size_t)e * D * EF, D, EF, gain, WSC1, WGUE + (size_t)e * EGU_N * D, 3, 0, r, lane);
    else if (r < 2 * I_E) tr_item<true>(wu + (size_t)e * D * EF, D, EF, gain, WSC1, WGUE + (size_t)e * EGU_N * D, 3, 128, r - I_E, lane);
    else tr_item<true>(wd + (size_t)e * EF * D, EF, D, nullptr, WSC2, WDNE + (size_t)e * D * EF, 0, 0, r - 2 * I_E, lane);
}
__device__ __forceinline__ void row_rms_to_bf16(const float* xrow, bf16_t* orow, int lane, float* inv) {
    const f32x4* xr = (const f32x4*)xrow + lane;
    f32x4 v[4]; float s = 0.f;
#pragma unroll
    for (int j = 0; j < 4; ++j) { v[j] = __builtin_nontemporal_load(xr + 64 * j); s += (v[j].x * v[j].x + v[j].y * v[j].y) + (v[j].z * v[j].z + v[j].w * v[j].w); }
    const float nrm = sqrtf(wave_sum(s) * (1.f / D) + RMS_EPS), rstd = 1.0f / nrm;
    if (lane == 0) *inv = nrm;
    u32x2* o8 = (u32x2*)orow + lane;
#pragma unroll
    for (int j = 0; j < 4; ++j) { u32x2 w; w.x = pk2(v[j].x * rstd, v[j].y * rstd); w.y = pk2(v[j].z * rstd, v[j].w * rstd); o8[64 * j] = w; }
}

__device__ __forceinline__ void row_rms_to_fp8(const float* xrow, unsigned char* orow, int lane) {
    const f32x4* xr = (const f32x4*)xrow + lane;
    f32x4 v[4]; float s = 0.f;
#pragma unroll
    for (int j = 0; j < 4; ++j) { v[j] = xr[64 * j]; s += (v[j].x * v[j].x + v[j].y * v[j].y) + (v[j].z * v[j].z + v[j].w * v[j].w); }
    const float rstd = 1.0f / sqrtf(wave_sum(s) * (1.f / D) + RMS_EPS);
    unsigned* o4 = (unsigned*)orow + lane;
#pragma unroll
    for (int j = 0; j < 4; ++j) { const f32x4 t = v[j] * rstd; o4[64 * j] = pk4f8(fclamp8(t.x), fclamp8(t.y), fclamp8(t.z), fclamp8(t.w)); }
}
constexpr int NWAVES = 8, NPHASE = 17;
struct Args { const float* in[22]; const int* pos; float* out; unsigned char* ws; int ph_lo, ph_hi; };

__global__ void __launch_bounds__(NWAVES * 64, 2) trunk_fwd(Args args) {
    extern __shared__ __attribute__((aligned(16))) unsigned char lds_raw[];
    LAS unsigned char* lds = (LAS unsigned char*)lds_raw;
    volatile LAS unsigned* MISC = (volatile LAS unsigned*)(lds + MISC_OFF);
    const int tid = threadIdx.x, lane = tid & 63, wave = __builtin_amdgcn_readfirstlane(tid >> 6);
    const int G = gridDim.x; const int bx = blockIdx.x; int vcu = (G % 8 == 0) ? (bx % 8) * (G / 8) + bx / 8 : bx;
    int gw = vcu * NWAVES + wave; const int NGW = G * NWAVES;
    int cb = bx; bool lok = false;
    unsigned char* ws = args.ws;
    unsigned* ctl = (unsigned*)(ws + WS_CTL);
    const float* x = args.in[0]; const int* positions = args.pos;
    const float* norm_attn = args.in[2]; const float* norm_ffn = args.in[3];
    const float* mla_w_down = args.in[4]; const float* mla_q_norm = args.in[5]; const float* mla_w_uq = args.in[6]; const float* mla_kv_norm = args.in[7];
    const float* mla_w_ukv = args.in[8]; const float* mla_w_o = args.in[9]; const float* dsw_kv_norm = args.in[10]; const float* dsw_w_kv = args.in[11];
    const float* dsw_w_q = args.in[12]; const float* dsw_w_o = args.in[13]; const float* ffn_w_gate = args.in[14]; const float* ffn_w_up = args.in[15];
    const float* ffn_w_down = args.in[16]; const float* moe_router = args.in[17]; const float* moe_w_gate = args.in[18]; const float* moe_w_up = args.in[19];
    const float* moe_w_down = args.in[20]; const float* final_norm = args.in[21];
    float* out = args.out;
    float* ROPEA = (float*)(ws + WS_ROPEA); float* ROPEB = (float*)(ws + WS_ROPEB);
    float* RG = (float*)(ws + WS_MISC + MISC_RG); int* TOKE = (int*)(ws + WS_MISC + MISC_TOKE); float* TOKG = (float*)(ws + WS_MISC + MISC_TOKG); int* TOKS = (int*)(ws + WS_MISC + MISC_TOKS);
    float* INV0 = (float*)(ws + WS_MISC + MISC_INV0);
    unsigned* CNT = (unsigned*)(ws + WS_MISC + MISC_CNT); unsigned* TILEE = (unsigned*)(ws + WS_MISC + MISC_TILEE); unsigned* NTILES = (unsigned*)(ws + WS_MISC + MISC_NT);
    bf16_t* WD = (bf16_t*)(ws + WS_WD); bf16_t* WUQ = (bf16_t*)(ws + WS_WUQ); bf16_t* WUKV = (bf16_t*)(ws + WS_WUKV); bf16_t* WO = (bf16_t*)(ws + WS_WO); bf16_t* WGU = (bf16_t*)(ws + WS_WGU);
    bf16_t* WDN = (bf16_t*)(ws + WS_WDN); bf16_t* WKVQ = (bf16_t*)(ws + WS_WKVQ); bf16_t* WO2 = (bf16_t*)(ws + WS_WO2);
    float* SSQ1 = (float*)(ws + WS_SSQ1); float* SSQ2 = (float*)(ws + WS_SSQ2); float* SSQD = (float*)(ws + WS_CQ);
    bf16_t* XN = (bf16_t*)(ws + WS_XN); bf16_t* DOWN = (bf16_t*)(ws + WS_DOWN); bf16_t* CQ = (bf16_t*)(ws + WS_CQ); bf16_t* CKV = (bf16_t*)(ws + WS_CKV); bf16_t* KR = (bf16_t*)(ws + WS_KR);
    bf16_t* Q = (bf16_t*)(ws + WS_Q); bf16_t* KV = (bf16_t*)(ws + WS_KV); bf16_t* O = (bf16_t*)(ws + WS_O); bf16_t* HID = (bf16_t*)(ws + WS_HID);
    bf16_t* KVQ = (bf16_t*)(ws + WS_KVQ); bf16_t* OG = (bf16_t*)(ws + WS_OG); float* LSE = (float*)(ws + WS_LSE); bf16_t* OM = (bf16_t*)(ws + WS_OM); unsigned char* X8 = ws + WS_X8;
    unsigned char* WGUE = ws + WS_WGUE; unsigned char* WDNE = ws + WS_WDNE; unsigned char* HN3 = ws + WS_HN3; unsigned char* XG = ws + WS_XG; bf16_t* YB = (bf16_t*)(ws + WS_YB); bf16_t* YT = (bf16_t*)(ws + WS_YT); unsigned char* HIDE = ws + WS_HIDE;

    for (int u = tid; u < (LDS_BYTES - LDSCTL_OFF) / 4; u += NWAVES * 64) ((LAS unsigned*)(lds + LDSCTL_OFF))[u] = 0u;
    __syncthreads();
    XcdBarrier bar; bar.bar = ctl + CW_BAR; bar.x = 0; bar.st = nullptr;
    if (!MK_PER_PHASE) bar = xcd_barrier_post(ctl + CW_BAR, MISC + 8);
    const int lo = args.ph_lo, hi = args.ph_hi;
#ifndef PH_MASK
#define PH_MASK 0x1FFFFu
#endif
#define IN(k) (lo <= (k) && (k) < hi && ((PH_MASK >> (k)) & 1u))
#ifndef REP_MASK
#define REP_MASK 0u
#endif
#ifndef REP_EXTRA
#define REP_EXTRA 1
#endif
#define REPS(k) (1 + REP_EXTRA * (int)((REP_MASK >> (k)) & 1u))
#ifndef DUP_MASK
#define DUP_MASK 0u
#endif
#define GDUP(k) (1 + REP_EXTRA * (int)((DUP_MASK >> (k)) & 1u))
#ifndef SEAM_REPS
#define SEAM_REPS 1
#endif
#define SEAM(k) do { if (IN(k) && IN((k) + 1)) { if (!MK_PER_PHASE) { for (int sr_ = 0; sr_ < SEAM_REPS; ++sr_) xcd_barrier(bar); } } } while (0)
#define SEAML(k) do { if (IN(k) && IN((k) + 1)) { if (!MK_PER_PHASE) { for (int sr_ = 0; sr_ < SEAM_REPS; ++sr_) { if (lok) xcd_barrier_local(bar); else xcd_barrier(bar); } } } } while (0)

    const bool split = (G == 256);
    constexpr int I_KVc = (D / 128) * (6144 / 32), I_Qc = (D / 128) * (3072 / 32), I_DNc = (FF / 128) * (D / 32), I_O2c = (D / 128) * (D / 32), LATE_ITEMS = I_KVc + I_Qc + I_DNc + I_O2c, MOE_EARLY = 6144, MOE_MID = 3584, MOE_P1 = 3072;
#define LATE_ITEM(r_) do { int q_ = (r_); \
        if (q_ < I_KVc) { tr_item<true>(dsw_w_kv, D, 6144, dsw_kv_norm, WSC1, WKVQ, 5, 0, q_, lane); break; } q_ -= I_KVc; \
        if (q_ < I_Qc)  { tr_item<true>(dsw_w_q, D, 3072, norm_attn + D, WSC1, WKVQ, 4, 6144, q_, lane); break; } q_ -= I_Qc; \
        if (q_ < I_DNc) { tr_item<(FFN8 != 0 || FFN8D != 0)>(ffn_w_down, FF, D, nullptr, (FFN8 || FFN8D) ? WSC2 : 1.0f, WDN, 0, 0, q_, lane); break; } q_ -= I_DNc; \
        tr_item<true>(dsw_w_o, D, D, nullptr, WSC1, WO2, 0, 0, q_, lane); } while (0)
    if (IN(0)) for (int rep_ = 0; rep_ < REPS(0); ++rep_) {
        constexpr int I_D = (D / 128) * (672 / 32), I_UQ = (QL / 128) * (UQ_N / 32), I_UKV = (KVL / 128) * (UKV_N / 32), I_O = (D / 128) * (D / 32), I_G = (D / 128) * (FF / 32);
        constexpr int NITEMS = I_D + I_UQ + I_UKV + I_O + 2 * I_G;
        for (int it = gw; it < NITEMS + LATE_ITEMS; it += NGW) {
            int r = it;
            if (r < I_G)   { tr_item<FFN8 != 0>(ffn_w_gate, D, FF, norm_ffn, FFN8 ? WSC1 : 1.0f, WGU, 3, 0, r, lane); continue; } r -= I_G;
            if (r < I_G)   { tr_item<FFN8 != 0>(ffn_w_up, D, FF, norm_ffn, FFN8 ? WSC1 : 1.0f, WGU, 3, 128, r, lane); continue; } r -= I_G;
            if (r < I_D)   { tr_item<false>(mla_w_down, D, 672, norm_attn, 1.0f, WD, 1, 0, r, lane); continue; } r -= I_D;
            if (r < I_UQ)  { tr_item<false>(mla_w_uq, QL, UQ_N, mla_q_norm, 1.0f, WUQ, 2, 0, r, lane); continue; } r -= I_UQ;
            if (r < I_UKV) { tr_item<false>(mla_w_ukv, KVL, UKV_N, mla_kv_norm, 1.0f, WUKV, 0, 0, r, lane); continue; } r -= I_UKV;
            if (r < I_O)   { tr_item<true>(mla_w_o, D, D, nullptr, WSC1, WO, 0, 0, r, lane); continue; } r -= I_O;
            LATE_ITEM(r);
        }
        for (int i = vcu * 512 + tid; i < 96 * 128; i += G * 512) ((u32x4*)(WD + (size_t)672 * D))[i] = (u32x4){0u, 0u, 0u, 0u};
        for (int i = vcu * 512 + tid; i < M * 24; i += G * 512) {
            const int m = i / 24, j = i % 24; const float p = (float)positions[m];
            float inv; float* dst;
            if (j < 16) { inv = exp2f(-(float)j * (18.931568569324174f / 16.0f)); dst = ROPEA + (size_t)m * 32 + 2 * j; }
            else { inv = exp2f(-(float)(j - 16) * (18.931568569324174f / 8.0f)); dst = ROPEB + (size_t)m * 16 + 2 * (j - 16); }
            float sn, cs; sincosf(p * inv, &sn, &cs); dst[0] = cs; dst[1] = sn;
        }
        for (int i = vcu * 512 + tid; i < NE * D; i += G * 512) { const int e = i / D, k = i % D; RG[i] = moe_router[k * NE + e] * norm_ffn[D + k]; }
        { constexpr int XR = 2; f32x4 nv[XR][4];
#pragma unroll
          for (int q = 0; q < XR; ++q) if (gw + q * NGW < M) { const f32x4* xr = (const f32x4*)(x + (size_t)(gw + q * NGW) * D) + lane;
#pragma unroll
              for (int j = 0; j < 4; ++j) nv[q][j] = __builtin_nontemporal_load(xr + 64 * j); }
          for (int m0 = gw; m0 < M; m0 += XR * NGW) {
              f32x4 v[XR][4];
#pragma unroll
              for (int q = 0; q < XR; ++q)
#pragma unroll
                  for (int j = 0; j < 4; ++j) v[q][j] = nv[q][j];
#pragma unroll
              for (int q = 0; q < XR; ++q) if (m0 + (XR + q) * NGW < M) { const f32x4* xr = (const f32x4*)(x + (size_t)(m0 + (XR + q) * NGW) * D) + lane;
#pragma unroll
                  for (int j = 0; j < 4; ++j) nv[q][j] = __builtin_nontemporal_load(xr + 64 * j); }
              asm volatile("" ::: "memory");
#pragma unroll
              for (int q = 0; q < XR; ++q) { const int m = m0 + q * NGW; if (m >= M) continue;
                  float s2 = 0.f;
#pragma unroll
                  for (int j = 0; j < 4; ++j) s2 += (v[q][j].x * v[q][j].x + v[q][j].y * v[q][j].y) + (v[q][j].z * v[q][j].z + v[q][j].w * v[q][j].w);
                  const float nrm = sqrtf(wave_sum(s2) * (1.f / D) + RMS_EPS), rstd = 1.0f / nrm;
                  if (lane == 0) INV0[m] = nrm;
                  u32x2* o8 = (u32x2*)(XN + (size_t)m * D) + lane;
#pragma unroll
                  for (int j = 0; j < 4; ++j) { u32x2 w; w.x = pk2(v[q][j].x * rstd, v[q][j].y * rstd); w.y = pk2(v[q][j].z * rstd, v[q][j].w * rstd); o8[64 * j] = w; } }
          } }
    }
    SEAM(0);
    if (!MK_PER_PHASE && IN(0) && IN(1)) { const unsigned ev = (unsigned)__builtin_amdgcn_readfirstlane(MISC[11]), rk = (unsigned)__builtin_amdgcn_readfirstlane(MISC[10]);
        if (ev != 0u && rk < 32u) { lok = true; vcu = (int)((ev - 1u) * 32u + rk); cb = (int)(rk * 8u + (ev - 1u)); gw = vcu * NWAVES + wave; } }
    if (IN(1)) for (int rep_ = 0; rep_ < REPS(1); ++rep_) {
        pg8::Gemm g{XN, WD, 2 * D, 2 * D, 2 * D, 0}; pg8::StaticOrder S; S.init(M / 256, DOWN_N / 256, G, cb, nullptr, GDUP(1));
        pg8::EpiDown E{DOWN, DOWN_N, SSQD, KR, ROPEA};
        pg8::gemm_phase<false>(lds, g, S, E);
        if (split && cb >= 192) { for (int it = MOE_EARLY + MOE_MID + (cb - 192) * NWAVES + wave; it < MOE_EARLY + MOE_MID + MOE_P1; it += 64 * NWAVES) moe_conv_item(it, moe_w_gate, moe_w_up, moe_w_down, norm_ffn + D, WGUE, WDNE, lane); }
    }
    SEAML(1);
    if (IN(3)) for (int rep_ = 0; rep_ < REPS(3); ++rep_) {
#ifndef P3SKIPA
        { pg8::Gemm g{DOWN, WUQ, 2 * QL, 2 * DOWN_N, 2 * QL, 0};   pg8::StaticOrder S; S.init(M / 256, UQ_N / 256, G, cb, nullptr, GDUP(3));
          pg8::EpiQRope E{Q, UQ_N, ROPEA, SSQD};
          pg8::gemm_phase<false>(lds, g, S, E);
          if (split && cb >= 128) { for (int it = MOE_EARLY + (cb - 128) * NWAVES + wave; it < MOE_EARLY + MOE_MID; it += 128 * NWAVES) moe_conv_item(it, moe_w_gate, moe_w_up, moe_w_down, norm_ffn + D, WGUE, WDNE, lane); } }
#endif
#ifndef P3SKIPB
        { pg8::Gemm g{DOWN + QL, WUKV, 2 * KVL, 2 * DOWN_N, 2 * KVL, 0};   pg8::StaticOrder S; S.init(M / 256, UKV_N / 256, G, cb, nullptr, GDUP(3));
          pg8::EpiBf16KV E{KV, UKV_N, SSQD};
          pg8::gemm_phase<false>(lds, g, S, E); }
#endif
    }
    SEAML(3);
    if (IN(4)) for (int rep_ = 0; rep_ < REPS(4); ++rep_) {
        for (int vid = vcu; vid < 256; vid += G) {
            const int b = vid >> 5, cset = (vid >> 3) & 3, kq = vid & 7;
            const size_t rb = (size_t)b * SEQ;
#define P4_UNIT(UU, i_) do { const int hh_ = 4 * (i_) + cset, qb_ = ((i_) & 1) ? 7 - kq : kq; \
                (UU).q = Q + rb * UQ_N + hh_ * 96; (UU).qs = UQ_N; \
                (UU).k1 = KV + rb * UKV_N + hh_ * 128; (UU).k1s = UKV_N; (UU).k2 = KR + rb * 32; (UU).k2s = 32; \
                (UU).v = KV + rb * UKV_N + hh_ * 128 + 64; (UU).vs = UKV_N; \
                (UU).o = (bf16_t*)((unsigned char*)O + rb * D + hh_ * 64); (UU).os = D; (UU).lse = nullptr; (UU).lses = 0;     \
                (UU).q0 = 256 * qb_; (UU).kt0 = 0; (UU).W = 1 << 30; } while (0)
            bf16x8 qf[6];
#pragma unroll
            for (int d0 = 0; d0 < 6; ++d0) qf[d0] = (bf16x8){0, 0, 0, 0, 0, 0, 0, 0};
#pragma unroll 1
            for (int i = 0; i < 4; ++i) {
                const int qb = (i & 1) ? 7 - kq : kq;
                att::Unit U, Un; P4_UNIT(U, i); P4_UNIT(Un, i < 3 ? i + 1 : i);
                att::attn_units<96, 1, false>(lds, U, 4 * (qb + 1), qf, i == 0, Un, i < 3);
            }
#undef P4_UNIT
        }
    }
    SEAML(4);
    if (IN(5)) for (int rep_ = 0; rep_ < REPS(5); ++rep_) {
        pg8::Gemm g{O, WO, D, D, D, 0}; pg8::StaticOrder S; S.init(M / 256, D / 256, G, cb, nullptr, GDUP(5));
        pg8::EpiResidB<1, false, true, (long)(WS_MISC + MISC_INV0) - (long)WS_XN> E{XN, XN, D, nullptr, SSQ1, 1.0f / (att::ATT_OSC * WSC1)};
        pg8::gemm_phase<true>(lds, g, S, E);
    }
    SEAML(5);
    if (IN(6) && DBG_STOP != 1) for (int rep_ = 0; rep_ < REPS(6); ++rep_) {
        pg8::StaticOrder S; S.init(M / 256, GU_N / 256, G, cb, nullptr, GDUP(6));
        if constexpr (FFN8) { pg8::Gemm g{XN, WGU, D, D, D, 0}; pg8::EpiSwiGLU8<true> E{(unsigned char*)HID, FF, 1.0f / WSC1, HSC, SSQ1}; pg8::gemm_phase<true>(lds, g, S, E); }
        else { pg8::Gemm g{XN, WGU, 2 * D, 2 * D, 2 * D, 0}; pg8::EpiSwiGLU<FFN8D != 0> E{HID, FF, SSQ1, HSC}; pg8::gemm_phase<false>(lds, g, S, E); }
        if (split && cb >= 128) { for (int it = (cb - 128) * NWAVES + wave; it < MOE_EARLY; it += 128 * NWAVES) moe_conv_item(it, moe_w_gate, moe_w_up, moe_w_down, norm_ffn + D, WGUE, WDNE, lane); }
    }
    SEAML(6);
    if (IN(7) && DBG_STOP != 1) for (int rep_ = 0; rep_ < REPS(7); ++rep_) {
        constexpr bool DN8 = (FFN8 != 0 || FFN8D != 0);
        pg8::Gemm g{HID, WDN, DN8 ? FF : 2 * FF, DN8 ? FF : 2 * FF, DN8 ? FF : 2 * FF, 0}; pg8::StaticOrder S; S.init(M / 256, D / 256, G, cb, nullptr, GDUP(7));
        pg8::EpiResidB<2, false> E{XN, XN, D, X8, SSQ2, DN8 ? 1.0f / (WSC2 * HSC) : 1.0f};
        pg8::gemm_phase<DN8>(lds, g, S, E);
    }
    SEAML(7);
    constexpr bool L1ON = (DBG_STOP == 0 || DBG_STOP >= 3);
    if (IN(8) && L1ON) for (int rep_ = 0; rep_ < REPS(8); ++rep_) {
        pg8::Gemm g{X8, WKVQ, D, D, D, 0}; pg8::StaticOrder S; S.init(M / 256, KVQ_N / 256, G, cb, nullptr, GDUP(8)); S.wgm = FP8_WGM;
        pg8::EpiKVQ E{(unsigned char*)KVQ, KVQ_N, ROPEB, 1.0f / WSC1, SSQ2};
        pg8::gemm_phase<true>(lds, g, S, E);
    }
    SEAML(8);
    if (IN(9) && L1ON) for (int rep_ = 0; rep_ < REPS(9); ++rep_) {
        const att::DswTensors T{(const unsigned char*)KVQ, (unsigned char*)OG, LSE};
        att::dsw_phase(lds, T, vcu, G);
    }
    SEAML(9);
    if (IN(10) && L1ON) for (int rep_ = 0; rep_ < REPS(10); ++rep_) {
#define P10_ROW(m0_) ((G == 256) ? (gw >> 8) * SEQ + (gw & 255) + 256 * ((m0_) >> 11) : (m0_))
#define P10_LOAD(q_, m_) do { _Pragma("unroll") for (int g3 = 0; g3 < 3; ++g3) { nl[q_][g3] = LSE[(size_t)g3 * M * 16 + (size_t)(m_) * 16 + (lane >> 2)]; na[q_][g3] = __builtin_nontemporal_load((const u32x4*)((const unsigned char*)OG + (size_t)g3 * M * D + (size_t)(m_) * D + 16 * lane)); } } while (0)
        constexpr int P10_R = 4;
        float nl[P10_R][3]; u32x4 na[P10_R][3];
#pragma unroll
        for (int q = 0; q < P10_R; ++q) if (gw + q * NGW < M) P10_LOAD(q, P10_ROW(gw + q * NGW));
        for (int m0 = gw; m0 < M; m0 += P10_R * NGW) {
            float l[P10_R][3]; u32x4 a[P10_R][3];
#pragma unroll
            for (int q = 0; q < P10_R; ++q)
#pragma unroll
                for (int g3 = 0; g3 < 3; ++g3) { l[q][g3] = nl[q][g3]; a[q][g3] = na[q][g3]; }
#pragma unroll
            for (int q = 0; q < P10_R; ++q) if (m0 + (P10_R + q) * NGW < M) P10_LOAD(q, P10_ROW(m0 + (P10_R + q) * NGW));
            asm volatile("" ::: "memory");
#pragma unroll
            for (int q = 0; q < P10_R; ++q) {
                if (m0 + q * NGW >= M) continue;
                const int m = P10_ROW(m0 + q * NGW);
                const float mx = fmaxf(l[q][0], fmaxf(l[q][1], l[q][2]));
                float w0 = __builtin_amdgcn_exp2f(l[q][0] - mx), w1 = __builtin_amdgcn_exp2f(l[q][1] - mx), w2 = __builtin_amdgcn_exp2f(l[q][2] - mx);
                const float inv = att::OM_SC / (w0 + w1 + w2); w0 *= inv; w1 *= inv; w2 *= inv;
                u32x4 o8;
#pragma unroll
                for (int j = 0; j < 4; ++j) {
                    const f32x2 x0 = __builtin_amdgcn_cvt_pk_f32_fp8(a[q][0][j], false), y0 = __builtin_amdgcn_cvt_pk_f32_fp8(a[q][0][j], true);
                    const f32x2 x1 = __builtin_amdgcn_cvt_pk_f32_fp8(a[q][1][j], false), y1 = __builtin_amdgcn_cvt_pk_f32_fp8(a[q][1][j], true);
                    const f32x2 x2 = __builtin_amdgcn_cvt_pk_f32_fp8(a[q][2][j], false), y2 = __builtin_amdgcn_cvt_pk_f32_fp8(a[q][2][j], true);
                    o8[j] = pk4f8(fclamp8(w0 * x0.x + w1 * x1.x + w2 * x2.x), fclamp8(w0 * x0.y + w1 * x1.y + w2 * x2.y), fclamp8(w0 * y0.x + w1 * y1.x + w2 * y2.x), fclamp8(w0 * y0.y + w1 * y1.y + w2 * y2.y)); }
                *(u32x4*)((unsigned char*)OM + (size_t)m * D + 16 * lane) = o8;
            }
        }
#undef P10_ROW
#undef P10_LOAD
    }
    SEAML(10);
    if (IN(11) && L1ON) for (int rep_ = 0; rep_ < REPS(11); ++rep_) {
        pg8::Gemm g{OM, WO2, D, D, D, 0}; pg8::StaticOrder S; S.init(M / 256, D / 256, G, cb, nullptr, GDUP(11));
        pg8::EpiResidB<0, false> E{XN, XN, D, nullptr, nullptr, 1.0f / (att::OM_SC * WSC1)};
        pg8::gemm_phase<true>(lds, g, S, E);
    }
    SEAML(11);
    constexpr bool MOEON = (DBG_STOP == 0);
    if (IN(12) && MOEON) for (int rep_ = 0; rep_ < REPS(12); ++rep_) {
        LAS unsigned* cntl = (LAS unsigned*)(lds + 32768); LAS int* tokl = (LAS int*)(lds + 32768 + 64);
        f32x4 rw[NE][4];
#pragma unroll
        for (int e = 0; e < NE; ++e)
#pragma unroll
            for (int j = 0; j < 4; ++j) rw[e][j] = *(const f32x4*)(RG + e * D + 4 * lane + 256 * j);
        for (int vb = vcu; vb < 256; vb += G) {
            if (tid < NE) cntl[tid] = 0u;
            __syncthreads();
            u32x2 nx[4];
            { const u32x2* xr = (const u32x2*)(XN + (size_t)(vb * 64 + wave * 8) * D) + lane;
#pragma unroll
              for (int j = 0; j < 4; ++j) nx[j] = xr[64 * j]; }
            for (int i = 0; i < 8; ++i) {
                const int m = vb * 64 + wave * 8 + i;
                f32x4 v[4]; float ss = 0.f; float lg[NE];
#pragma unroll
                for (int e = 0; e < NE; ++e) lg[e] = 0.f;
#pragma unroll
                for (int j = 0; j < 4; ++j) v[j] = (f32x4){bflo(nx[j].x), bfhi(nx[j].x), bflo(nx[j].y), bfhi(nx[j].y)};
                if (i + 1 < 8) { const u32x2* xr = (const u32x2*)(XN + (size_t)(m + 1) * D) + lane;
#pragma unroll
                    for (int j = 0; j < 4; ++j) nx[j] = xr[64 * j]; }
#pragma unroll
                for (int j = 0; j < 4; ++j) { ss += (v[j].x * v[j].x + v[j].y * v[j].y) + (v[j].z * v[j].z + v[j].w * v[j].w);
#pragma unroll
                    for (int e = 0; e < NE; ++e) { const f32x4 w = rw[e][j]; lg[e] += (v[j].x * w.x + v[j].y * w.y) + (v[j].z * w.z + v[j].w * w.w); } }
                const float rstd = 1.0f / sqrtf(wave_sum(ss) * (1.f / D) + RMS_EPS);
#pragma unroll
                for (int e = 0; e < NE; ++e) lg[e] = wave_sum(lg[e]) * rstd;
                int i1 = 0; float v1 = lg[0];
#pragma unroll
                for (int e = 1; e < NE; ++e) if (lg[e] > v1) { v1 = lg[e]; i1 = e; }
                int i2 = -1; float v2 = -INFINITY;
#pragma unroll
                for (int e = 0; e < NE; ++e) if (e != i1 && lg[e] > v2) { v2 = lg[e]; i2 = e; }
                const float g1 = 1.0f / (1.0f + expf(v2 - v1)), g2 = 1.0f - g1;
                if (lane == 0) { TOKE[2 * m] = i1; TOKE[2 * m + 1] = i2; TOKG[2 * m] = g1; TOKG[2 * m + 1] = g2; tokl[2 * (wave * 8 + i)] = i1; tokl[2 * (wave * 8 + i) + 1] = i2;
                    __hip_atomic_fetch_add(cntl + i1, 1u, __ATOMIC_RELAXED, __HIP_MEMORY_SCOPE_WORKGROUP); __hip_atomic_fetch_add(cntl + i2, 1u, __ATOMIC_RELAXED, __HIP_MEMORY_SCOPE_WORKGROUP); }
                if (split) { LAS unsigned* o4 = (LAS unsigned*)(lds + P12_ROWS_OFF + (wave * 8 + i) * D) + lane;
#pragma unroll
                    for (int j = 0; j < 4; ++j) { const f32x4 t = v[j] * rstd; o4[64 * j] = pk4f8(fclamp8(t.x), fclamp8(t.y), fclamp8(t.z), fclamp8(t.w)); } }
                else { unsigned* o4 = (unsigned*)(HN3 + (size_t)m * D) + lane;
#pragma unroll
                    for (int j = 0; j < 4; ++j) { const f32x4 t = v[j] * rstd; o4[64 * j] = pk4f8(fclamp8(t.x), fclamp8(t.y), fclamp8(t.z), fclamp8(t.w)); } }
            }
            __syncthreads();
            if (tid < NE) __hip_atomic_store(CNT + vb * NE + tid, cntl[tid], __ATOMIC_RELAXED, __HIP_MEMORY_SCOPE_AGENT);
            __syncthreads();
        }
        asm volatile("s_waitcnt vmcnt(0)" ::: "memory");
        __syncthreads();
        if (tid == 0) __hip_atomic_fetch_add(ctl + CW_RDY, 1u, __ATOMIC_RELAXED, __HIP_MEMORY_SCOPE_AGENT);
        for (int it = (split ? MOE_EARLY + MOE_MID + MOE_P1 : 0) + gw; it < MOE_ITEMS - MOE_TAIL; it += NGW) moe_conv_item(it, moe_w_gate, moe_w_up, moe_w_down, norm_ffn + D, WGUE, WDNE, lane);
        if (tid == 0) {
            unsigned sp = 0u;
            while (__hip_atomic_load(ctl + CW_RDY, __ATOMIC_RELAXED, __HIP_MEMORY_SCOPE_AGENT) < (unsigned)G) { __builtin_amdgcn_s_sleep(1);
                if ((++sp & 255u) == 0u) { if (__hip_atomic_load(ctl + CW_BAR + XB_TMO, __ATOMIC_RELAXED, __HIP_MEMORY_SCOPE_AGENT)) break; if (sp > XB_SPIN_CAP) { atomicAdd(ctl + CW_BAR + XB_TMO, 1u); break; } } } }
        __syncthreads();
        {
        LAS unsigned* sl = (LAS unsigned*)lds;
        for (int vb = vcu; vb < 256; vb += G) {
            { unsigned c4[4];
#pragma unroll
              for (int q = 0; q < 4; ++q) c4[q] = __hip_atomic_load(CNT + tid + 512 * q, __ATOMIC_RELAXED, __HIP_MEMORY_SCOPE_AGENT);
              if (tid < 16) sl[tid] = 0u;
              __syncthreads();
              unsigned tot = 0u, pre = 0u;
#pragma unroll
              for (int q = 0; q < 4; ++q) { tot += c4[q]; pre += ((tid >> 3) + 64 * q < vb) ? c4[q] : 0u; }
#pragma unroll
              for (int o = 8; o < 64; o <<= 1) { tot += __shfl_xor(tot, o); pre += __shfl_xor(pre, o); }
              if (lane < NE) { __hip_atomic_fetch_add(sl + lane, tot, __ATOMIC_RELAXED, __HIP_MEMORY_SCOPE_WORKGROUP); __hip_atomic_fetch_add(sl + 8 + lane, pre, __ATOMIC_RELAXED, __HIP_MEMORY_SCOPE_WORKGROUP); } }
            __syncthreads();
            if (wave == 0) {
                const unsigned tt = lane < NE ? sl[lane] : 0u, pr = lane < NE ? sl[8 + lane] : 0u, pad = (tt + 255u) & ~255u;
                unsigned inc = pad;
#pragma unroll
                for (int o = 1; o < NE; o <<= 1) { const unsigned nb_ = __shfl_up(inc, o); if (lane >= o) inc += nb_; }
                const unsigned base = inc - pad;
                if (vb == 0 && lane < NE) { for (unsigned t2 = base / 256u; t2 < (base + pad) / 256u; ++t2) __hip_atomic_store(TILEE + t2, (unsigned)lane, __ATOMIC_RELAXED, __HIP_MEMORY_SCOPE_AGENT);
                    if (lane == NE - 1) __hip_atomic_store(NTILES, inc / 256u, __ATOMIC_RELAXED, __HIP_MEMORY_SCOPE_AGENT); }
                const int m = vb * 64 + lane; unsigned run[NE];
#pragma unroll
                for (int e = 0; e < NE; ++e) run[e] = __shfl(base + pr, e);
#pragma unroll
                for (int k = 0; k < 2; ++k) { const int ek = split ? tokl[2 * lane + k] : TOKE[2 * m + k]; unsigned slot = 0u;
#pragma unroll
                    for (int e = 0; e < NE; ++e) { const unsigned long long mask = __ballot(ek == e); const unsigned below = (unsigned)__popcll(mask & ((1ull << lane) - 1ull));
                        if (ek == e) slot = run[e] + below; run[e] += (unsigned)__popcll(mask); }
                    TOKS[2 * m + k] = (int)slot; sl[32 + 2 * lane + k] = slot; }
            }
            __syncthreads();
            for (int i = 0; i < 8; ++i) { const int lr = wave * 8 + i, m = vb * 64 + lr; const u32x4 a0 = split ? ((const LAS u32x4*)(lds + P12_ROWS_OFF + lr * D))[lane] : ((const u32x4*)(HN3 + (size_t)m * D))[lane];
#pragma unroll
                for (int k = 0; k < 2; ++k) ((u32x4*)(XG + (size_t)sl[32 + 2 * lr + k] * D))[lane] = a0; }
            __syncthreads();
        }
        }
    }
    SEAM(13);
    int ntl_keep = 0; bool have_tbl = false;
    if (IN(14) && MOEON) for (int rep_ = 0; rep_ < REPS(14); ++rep_) {
        const unsigned nraw = __hip_atomic_load(NTILES, __ATOMIC_RELAXED, __HIP_MEMORY_SCOPE_AGENT);
        unsigned te_ = 0u; if (tid < RMAX / 256) te_ = __hip_atomic_load(TILEE + tid, __ATOMIC_RELAXED, __HIP_MEMORY_SCOPE_AGENT);
        const int ntl = (int)__builtin_amdgcn_readfirstlane(nraw); ntl_keep = ntl; have_tbl = true;
        LAS unsigned* tel = (LAS unsigned*)(lds + pg8::STAGE_BYTES + 2048);
        if (tid < RMAX / 256) tel[tid] = te_;
        __syncthreads();
        pg8::Gemm g{XG, WGUE, D, D, D, (size_t)EGU_N * D}; pg8::StaticOrder S; S.init(ntl, EGU_N / 256, G, cb, tel, GDUP(14)); S.wgm = FP8_WGM;
        pg8::EpiSwiGLU8<false> E{HIDE, EF, 1.0f / WSC1, HSC, nullptr};
        pg8::gemm_phase<true>(lds, g, S, E);
        { const int nun = ntl * (EGU_N / 256), rem = nun % G, nidle = rem ? G - rem : 0; int na = nidle * P14_IA; if (na > MOE_TAIL) na = MOE_TAIL;
          if (rem && cb >= rem) for (int it = (cb - rem) * NWAVES + wave; it < na; it += nidle * NWAVES) moe_conv_item(MOE_ITEMS - MOE_TAIL + it, moe_w_gate, moe_w_up, moe_w_down, norm_ffn + D, WGUE, WDNE, lane);
          int gr = cb - rem; if (gr < 0) gr += G; gr = gr * NWAVES + wave;
          for (int it = na + gr; it < MOE_TAIL; it += NGW) moe_conv_item(MOE_ITEMS - MOE_TAIL + it, moe_w_gate, moe_w_up, moe_w_down, norm_ffn + D, WGUE, WDNE, lane); }
    }
    SEAM(14);
    if (IN(15) && MOEON) for (int rep_ = 0; rep_ < REPS(15); ++rep_) {
        LAS unsigned* tel = (LAS unsigned*)(lds + pg8::STAGE_BYTES + 2048);
        int ntl = ntl_keep;
        if (!have_tbl) { ntl = (int)__builtin_amdgcn_readfirstlane(__hip_atomic_load(NTILES, __ATOMIC_RELAXED, __HIP_MEMORY_SCOPE_AGENT));
            for (int i = tid; i < ntl; i += NWAVES * 64) tel[i] = __hip_atomic_load(TILEE + i, __ATOMIC_RELAXED, __HIP_MEMORY_SCOPE_AGENT);
            __syncthreads(); }
        { pg8::Gemm g{HIDE, WDNE, EF, EF, EF, (size_t)D * EF}; pg8::StaticOrder S; S.init(ntl < P15_MAIN ? ntl : P15_MAIN, D / 256, G, cb, tel, GDUP(15));
          pg8::EpiF8 E{(unsigned char*)YB, D, YSC / (WSC2 * HSC)};
          pg8::gemm_phase<true>(lds, g, S, E); }
        { pg8::Gemm g{HIDE, WDNE, EF / P15_NS, EF, EF, (size_t)D * EF, EF / P15_NS}; pg8::SliceOrder S; S.init(P15_MAIN, ntl - P15_MAIN, D / 256, P15_NS, G, cb, tel);
          pg8::EpiBf16S E{YT, D, 1.0f / (WSC2 * HSC), P15_MAIN, (size_t)YT_ROWS * D};
          pg8::gemm_phase<true>(lds, g, S, E); }
    }
    int sl[2][2], nsl[2][2]; float gg[2][2], ngg[2][2];
#define P16_TOK(m0_, S_, G_) do { _Pragma("unroll") for (int q = 0; q < 2; ++q) { const int mm = ((m0_) + q * NGW < M) ? (m0_) + q * NGW : (m0_); \
            S_[q][0] = 0; S_[q][1] = 0; G_[q][0] = 0.f; G_[q][1] = 0.f; \
            if (MOEON) { S_[q][0] = TOKS[2 * mm]; S_[q][1] = TOKS[2 * mm + 1]; G_[q][0] = TOKG[2 * mm]; G_[q][1] = TOKG[2 * mm + 1]; } } } while (0)
    if (gw < M) { P16_TOK(gw, sl, gg); }
    SEAM(15);
    if (IN(16)) {
        const unsigned tmo = __hip_atomic_load(ctl + CW_BAR + XB_TMO, __ATOMIC_RELAXED, __HIP_MEMORY_SCOPE_AGENT);
        constexpr int TAIL0 = P15_MAIN * 256;
        u32x2 hb[2][4]; unsigned y8[2][2][4];
#define P16_ROWS(m0_, S_) do { _Pragma("unroll") for (int q = 0; q < 2; ++q) { const int mm = ((m0_) + q * NGW < M) ? (m0_) + q * NGW : (m0_); const u32x2* hr = (const u32x2*)(XN + (size_t)mm * D) + lane; \
            _Pragma("unroll") for (int j = 0; j < 4; ++j) hb[q][j] = __builtin_nontemporal_load(hr + 64 * j); \
            _Pragma("unroll") for (int k = 0; k < 2; ++k) { const int sk = S_[q][k] < TAIL0 ? S_[q][k] : 0; const unsigned* y = (const unsigned*)((const unsigned char*)YB + (size_t)sk * D) + lane; \
                _Pragma("unroll") for (int j = 0; j < 4; ++j) y8[q][k][j] = MOEON ? __builtin_nontemporal_load(y + 64 * j) : 0u; } } } while (0)
        if (gw < M) { P16_ROWS(gw, sl); }
        for (int m0 = gw; m0 < M; m0 += 2 * NGW) {
            const bool more = m0 + 2 * NGW < M;
            if (more) P16_TOK(m0 + 2 * NGW, nsl, ngg);
            f32x4 res[2][4];
#pragma unroll
            for (int q = 0; q < 2; ++q) {
                f32x4 v[4]; float ss = 0.f;
                const bool t1 = sl[q][0] >= TAIL0, t2 = sl[q][1] >= TAIL0;
                const float k1 = t1 ? 0.f : gg[q][0] * (1.0f / YSC), k2 = t2 ? 0.f : gg[q][1] * (1.0f / YSC);
#pragma unroll
                for (int j = 0; j < 4; ++j) { v[j] = (f32x4){bflo(hb[q][j].x), bfhi(hb[q][j].x), bflo(hb[q][j].y), bfhi(hb[q][j].y)};
                    const f32x2 al = __builtin_amdgcn_cvt_pk_f32_fp8(y8[q][0][j], false), ah = __builtin_amdgcn_cvt_pk_f32_fp8(y8[q][0][j], true), bl = __builtin_amdgcn_cvt_pk_f32_fp8(y8[q][1][j], false), bh = __builtin_amdgcn_cvt_pk_f32_fp8(y8[q][1][j], true);
                    v[j].x += k1 * al.x + k2 * bl.x; v[j].y += k1 * al.y + k2 * bl.y; v[j].z += k1 * ah.x + k2 * bh.x; v[j].w += k1 * ah.y + k2 * bh.y; }
                if (MOEON && (t1 || t2)) {
                    const float h1 = t1 ? gg[q][0] : 0.f, h2 = t2 ? gg[q][1] : 0.f;
                    const u32x2* y1 = (const u32x2*)(YT + (size_t)(t1 ? sl[q][0] - TAIL0 : 0) * D) + lane; const u32x2* y2 = (const u32x2*)(YT + (size_t)(t2 ? sl[q][1] - TAIL0 : 0) * D) + lane;
                    for (int ks = 0; ks < P15_NS; ++ks) { const u32x2* z1 = y1 + (size_t)ks * YT_ROWS * (D / 4); const u32x2* z2 = y2 + (size_t)ks * YT_ROWS * (D / 4);
#pragma unroll
                        for (int j = 0; j < 4; ++j) { const u32x2 a = z1[64 * j], b = z2[64 * j];
                            v[j].x += h1 * bflo(a.x) + h2 * bflo(b.x); v[j].y += h1 * bfhi(a.x) + h2 * bfhi(b.x); v[j].z += h1 * bflo(a.y) + h2 * bflo(b.y); v[j].w += h1 * bfhi(a.y) + h2 * bfhi(b.y); } } }
#pragma unroll
                for (int j = 0; j < 4; ++j) ss += (v[j].x * v[j].x + v[j].y * v[j].y) + (v[j].z * v[j].z + v[j].w * v[j].w);
                float rstd = 1.0f / sqrtf(wave_sum(ss) * (1.f / D) + RMS_EPS);
                if (tmo) rstd = __builtin_nanf("");
#pragma unroll
                for (int j = 0; j < 4; ++j) { const f32x4 gn = *((const f32x4*)final_norm + lane + 64 * j); res[q][j] = v[j] * rstd * gn; }
            }
            if (more) { P16_ROWS(m0 + 2 * NGW, nsl); asm volatile("" ::: "memory"); }
#pragma unroll
            for (int q = 0; q < 2; ++q) { const int m = m0 + q * NGW; if (m < M) { f32x4* xr = (f32x4*)(out + (size_t)m * D) + lane;
#pragma unroll
                for (int j = 0; j < 4; ++j) __builtin_nontemporal_store(res[q][j], xr + 64 * j); } }
#pragma unroll
            for (int q = 0; q < 2; ++q) { sl[q][0] = nsl[q][0]; sl[q][1] = nsl[q][1]; gg[q][0] = ngg[q][0]; gg[q][1] = ngg[q][1]; }
        }
#undef P16_TOK
#undef P16_ROWS
    }
#undef IN
#undef SEAM
}

extern "C" void kernel_launch(void* const* d_in, const int* in_sizes, int n_in, void* d_out, int out_size, void* d_ws, size_t ws_size, hipStream_t stream) {
    static int grid = 0;
    if (grid == 0) {
        if (n_in != 22 || in_sizes[0] != M * D || out_size != M * D || ws_size < WS_END) {
            fprintf(stderr, "kernel_launch: unexpected problem (n_in %d, in0 %d, out %d, ws %zu); nothing launched\n", n_in, n_in > 0 ? in_sizes[0] : -1, out_size, ws_size); grid = -1; return; }
        int dev = 0, cus = 0, per_cu = 0;
        if (hipGetDevice(&dev) != hipSuccess || hipDeviceGetAttribute(&cus, hipDeviceAttributeMultiprocessorCount, dev) != hipSuccess) { grid = -1; return; }
        if (hipFuncSetAttribute((const void*)trunk_fwd, hipFuncAttributeMaxDynamicSharedMemorySize, LDS_BYTES) != hipSuccess) { fprintf(stderr, "kernel_launch: hipFuncSetAttribute failed\n"); grid = -1; return; }
        if (hipOccupancyMaxActiveBlocksPerMultiprocessor(&per_cu, (const void*)trunk_fwd, NWAVES * 64, LDS_BYTES) != hipSuccess || per_cu < 1)
            fprintf(stderr, "kernel_launch: note: occupancy query reports %d workgroups per CU\n", per_cu);
        (void)hipGetLastError();
        grid = cus;
    }
    if (grid < 0) return;
    (void)hipMemsetAsync((char*)d_ws + WS_CTL, 0, CTL_ZERO_BYTES, stream);
    Args a{};
    for (int i = 0; i < 22; ++i) a.in[i] = (const float*)d_in[i];
    a.pos = (const int*)d_in[1]; a.out = (float*)d_out; a.ws = (unsigned char*)d_ws;
#if MK_PER_PHASE
    for (int p = 0; p < NPHASE; ++p) { a.ph_lo = p; a.ph_hi = p + 1; hipLaunchKernelGGL(trunk_fwd, dim3(grid), dim3(NWAVES * 64), LDS_BYTES, stream, a); }
#else
    a.ph_lo = 0; a.ph_hi = NPHASE;
    hipLaunchKernelGGL(trunk_fwd, dim3(grid), dim3(NWAVES * 64), LDS_BYTES, stream, a);
#endif
    const hipError_t le = hipPeekAtLastError();
    if (le != hipSuccess) fprintf(stderr, "kernel_launch: launch failed: %s\n", hipGetErrorName(le));
}
```
